# Optimizing an MI355X kernel written in HIP

```python
import jax, jax.numpy as jnp
from jax import lax
import numpy as np

D_MODEL = 1024
BATCH = 8
SEQ = 2048
DEPTH = 2
DEC_BATCH = 128
DEC_SEQ = 4
PAST_LEN = 16384
PAGE_SIZE = 128

N_MEM = 256
ATT_HEADS = 4
ATT_HEAD_DIM = D_MODEL // ATT_HEADS
ATT_WIDTH = ATT_HEADS * ATT_HEAD_DIM
W_CONV = D_MODEL
CONV_WIDTH = 3
W_POOL = D_MODEL
POOL_WINDOWS = (2, 4, 8, 16)
N_POOL_GROUPS = 4
POOL_GROUP = W_POOL // N_POOL_GROUPS
POOL_STATE = 15
EPS = 1e-6
IN_SPLITS = (W_CONV, W_CONV, W_CONV, W_CONV, W_POOL, W_POOL, ATT_WIDTH, ATT_WIDTH, D_MODEL, D_MODEL, D_MODEL)
D_IN = sum(IN_SPLITS)

kernel_name = "hybrid_conv_pool_memxattn_decoder_step"


def rmsnorm(x, g):
    xf = x.astype(jnp.float32)
    y = xf * lax.rsqrt(jnp.mean(xf * xf, axis=-1, keepdims=True) + EPS)
    return (y * g.astype(jnp.float32)).astype(x.dtype)


def mem_keys_values(mem, g, w_kv):
    kv = rmsnorm(mem, g) @ w_kv
    k, v = jnp.split(kv, 2, axis=-1)
    b = mem.shape[0]
    return (k.reshape(b, N_MEM, ATT_HEADS, ATT_HEAD_DIM),
            v.reshape(b, N_MEM, ATT_HEADS, ATT_HEAD_DIM))


def causal_multiscale_pool(p_ext, pos):
    b, l, _ = p_ext.shape
    t = l - POOL_STATE
    pf = p_ext.astype(jnp.float32).reshape(b, l, N_POOL_GROUPS, POOL_GROUP)
    cs = jnp.concatenate([jnp.zeros_like(pf[:, :1]), jnp.cumsum(pf, axis=1)], axis=1)
    end = cs[:, POOL_STATE + 1:]
    means = []
    for g, w in enumerate(POOL_WINDOWS):
        start = cs[:, POOL_STATE + 1 - w: POOL_STATE + 1 - w + t, g]
        cnt = jnp.minimum(pos + 1, w).astype(jnp.float32)[None, :, None]
        means.append((end[:, :, g] - start) / cnt)
    mean = jnp.stack(means, axis=2)
    return mean - pf[:, POOL_STATE:]


def layer(x, mem_k, mem_v, conv_prev, pool_prev, pos,
          norm_g, w_in, conv_w, pool_w, pool_scale, w_br_conv, w_br_pool, w_br_att, w_out):
    b, t, _ = x.shape
    h = rmsnorm(x, norm_g)
    z = h @ w_in
    idx = np.cumsum(IN_SPLITS)[:-1].tolist()
    hc, bc, cc, gc, hp, gp, q, ga, mc, mp, ma = jnp.split(z, idx, axis=-1)

    u = cc * hc
    u_ext = jnp.concatenate([conv_prev.astype(u.dtype), u], axis=1)
    y_conv = conv_w[0] * u_ext[:, 0:t]
    for k in range(1, CONV_WIDTH):
        y_conv = y_conv + conv_w[k] * u_ext[:, k:k + t]
    conv_br = (bc * y_conv * jax.nn.silu(gc)) @ w_br_conv

    p_ext = jnp.concatenate([pool_prev.astype(hp.dtype), hp], axis=1)
    mixed = causal_multiscale_pool(p_ext, pos)
    pooled = jnp.einsum('btgc,gcd->btgd', mixed, pool_w.astype(jnp.float32))
    pooled = pooled.reshape(b, t, W_POOL).astype(x.dtype) * pool_scale
    pool_br = (pooled * jax.nn.silu(gp)) @ w_br_pool

    qh = q.reshape(b, t, ATT_HEADS, ATT_HEAD_DIM)
    s = jnp.einsum('bthd,bmhd->bhtm', qh, mem_k).astype(jnp.float32) * (ATT_HEAD_DIM ** -0.5)
    p = jax.nn.softmax(s, axis=-1).astype(x.dtype)
    o = jnp.einsum('bhtm,bmhd->bthd', p, mem_v).reshape(b, t, ATT_WIDTH)
    att_br = (o * jax.nn.silu(ga)) @ w_br_att

    merged = (jax.nn.sigmoid(mc) * conv_br + jax.nn.sigmoid(mp) * pool_br
              + jax.nn.sigmoid(ma) * att_br)
    x_new = x + merged @ w_out
    return x_new, u_ext[:, -(CONV_WIDTH - 1):], p_ext[:, -POOL_STATE:]


def setup_inputs(seed: int = 0) -> dict:
    key = jax.random.key(seed)
    ks = jax.random.split(key, 24)
    f32 = jnp.float32
    nrm = lambda k, shape, scale: jax.random.normal(k, shape, f32) * scale
    return {
        "x_prompt": nrm(ks[0], (BATCH, SEQ, D_MODEL), 1.0),
        "x_sample": nrm(ks[1], (DEC_BATCH, DEC_SEQ, D_MODEL), 1.0),
        "mem_prompt": nrm(ks[2], (BATCH, N_MEM, D_MODEL), 1.0),
        "cache_mem_k": nrm(ks[3], (DEPTH, DEC_BATCH, N_MEM, ATT_HEADS, ATT_HEAD_DIM), 1.0),
        "cache_mem_v": nrm(ks[4], (DEPTH, DEC_BATCH, N_MEM, ATT_HEADS, ATT_HEAD_DIM), 1.0),
        "state_conv": nrm(ks[5], (DEPTH, DEC_BATCH, CONV_WIDTH - 1, W_CONV), 1.0),
        "state_pool": nrm(ks[6], (DEPTH, DEC_BATCH, POOL_STATE, W_POOL), 1.0),
        "norm_g": 1.0 + nrm(ks[7], (DEPTH, D_MODEL), 0.05),
        "w_in": nrm(ks[8], (DEPTH, D_MODEL, D_IN), D_MODEL ** -0.5),
        "conv_w": nrm(ks[9], (DEPTH, CONV_WIDTH, W_CONV), CONV_WIDTH ** -0.5),
        "pool_w": nrm(ks[10], (DEPTH, N_POOL_GROUPS, POOL_GROUP, POOL_GROUP), POOL_GROUP ** -0.5),
        "pool_scale": 1.0 + nrm(ks[11], (DEPTH, W_POOL), 0.1),
        "mem_norm_g": 1.0 + nrm(ks[12], (DEPTH, D_MODEL), 0.05),
        "w_mem_kv": nrm(ks[13], (DEPTH, D_MODEL, 2 * ATT_WIDTH), D_MODEL ** -0.5),
        "w_br_conv": nrm(ks[14], (DEPTH, W_CONV, D_MODEL), W_CONV ** -0.5),
        "w_br_pool": nrm(ks[15], (DEPTH, W_POOL, D_MODEL), W_POOL ** -0.5),
        "w_br_att": nrm(ks[16], (DEPTH, ATT_WIDTH, D_MODEL), ATT_WIDTH ** -0.5),
        "w_out": nrm(ks[17], (DEPTH, D_MODEL, D_MODEL), D_MODEL ** -0.5),
        "final_norm_g": 1.0 + nrm(ks[18], (D_MODEL,), 0.05),
    }


def reference(x_prompt, x_sample, mem_prompt, cache_mem_k, cache_mem_v, state_conv, state_pool,
              norm_g, w_in, conv_w, pool_w, pool_scale, mem_norm_g, w_mem_kv,
              w_br_conv, w_br_pool, w_br_att, w_out, final_norm_g):
    b_p, t_p, _ = x_prompt.shape
    t_s = x_sample.shape[1]
    pos_p = jnp.arange(t_p, dtype=jnp.int32)
    pos_s = PAST_LEN + jnp.arange(t_s, dtype=jnp.int32)
    xp, xs = x_prompt, x_sample
    mk_p, mv_p, cv_p, pl_p, cv_s, pl_s = [], [], [], [], [], []
    for l in range(DEPTH):
        lw = (norm_g[l], w_in[l], conv_w[l], pool_w[l], pool_scale[l],
              w_br_conv[l], w_br_pool[l], w_br_att[l], w_out[l])
        k_p, v_p = mem_keys_values(mem_prompt, mem_norm_g[l], w_mem_kv[l])
        conv0 = jnp.zeros((b_p, CONV_WIDTH - 1, W_CONV), xp.dtype)
        pool0 = jnp.zeros((b_p, POOL_STATE, W_POOL), xp.dtype)
        xp, c_new, p_new = layer(xp, k_p, v_p, conv0, pool0, pos_p, *lw)
        mk_p.append(k_p); mv_p.append(v_p); cv_p.append(c_new); pl_p.append(p_new)
        xs, c_new_s, p_new_s = layer(xs, cache_mem_k[l], cache_mem_v[l], state_conv[l], state_pool[l],
                                     pos_s, *lw)
        cv_s.append(c_new_s); pl_s.append(p_new_s)
    y_prompt = rmsnorm(xp, final_norm_g)
    y_sample = rmsnorm(xs, final_norm_g)
    return (y_prompt, y_sample, jnp.stack(mk_p), jnp.stack(mv_p), jnp.stack(cv_p), jnp.stack(pl_p),
            jnp.stack(cv_s), jnp.stack(pl_s))
```

```cpp
#include <hip/hip_runtime.h>
#include <cstdio>
#ifndef REP_PH
#define REP_PH 0
#endif
#include <cstdint>

#define LAS __attribute__((address_space(3)))
#define GAS __attribute__((address_space(1)))
typedef unsigned short bf16_t;
typedef short bf16x8 __attribute__((ext_vector_type(8)));
typedef float f32x4 __attribute__((ext_vector_type(4)));
typedef float f32x2 __attribute__((ext_vector_type(2)));
typedef unsigned u32x4 __attribute__((ext_vector_type(4)));
typedef unsigned u32x2 __attribute__((ext_vector_type(2)));

constexpr int DM = 1024;
constexpr int NBATCH = 8, SEQ = 2048, DEPTH = 2, DBATCH = 128, DSEQ = 4;
constexpr int MP = NBATCH * SEQ;
constexpr int MS = DBATCH * DSEQ;
constexpr int MT = MP + MS;
constexpr int NMEM = 256, NHEAD = 4, HDIM = 256;
constexpr int DIN = 11 * DM;
constexpr float EPS = 1e-6f;
constexpr float LOG2E = 1.4426950408889634f;

constexpr size_t MiB = 1u << 20;
constexpr size_t SLOT = 33 * MiB;
constexpr size_t WS_CTL = 0, CTL_ZERO_BYTES = 1 * MiB;
constexpr size_t WS_WIN = 1 * MiB;
constexpr size_t WS_WKV = 45 * MiB;
constexpr size_t WS_WBR = 53 * MiB;
constexpr size_t WS_WO = 65 * MiB;
constexpr size_t WS_PW = 69 * MiB;
constexpr size_t WS_HM = 70 * MiB;
constexpr size_t WS_KB = 78 * MiB;
constexpr size_t WS_VT = 82 * MiB;
constexpr size_t WS_XG = 86 * MiB;
constexpr size_t WS_Z = 119 * MiB;
constexpr size_t WS_PS = WS_Z + 9 * SLOT;
constexpr size_t WS_MIX = WS_PS + SLOT;
constexpr size_t WS_ACONV = WS_MIX + SLOT;
constexpr size_t WS_APOOL = WS_ACONV + SLOT;
constexpr size_t WS_AATT = WS_APOOL + SLOT;
constexpr size_t WS_MRG = WS_AATT + SLOT;
constexpr size_t WS_XNEW = WS_MRG + SLOT;
constexpr size_t WS_END = WS_XNEW + 66 * MiB;
enum ZSlot { Z_U = 0, Z_BS, Z_HP, Z_SGP, Z_Q, Z_SGA, Z_SMC, Z_SMP, Z_SMA };
constexpr int CW_BAR = 4096;
constexpr int CW_RSS = 32768;

constexpr size_t O_YP = 0;
constexpr size_t O_YS = O_YP + (size_t)MP * DM;
constexpr size_t O_MK = O_YS + (size_t)MS * DM;
constexpr size_t O_MV = O_MK + (size_t)DEPTH * NBATCH * NMEM * DM;
constexpr size_t O_CP = O_MV + (size_t)DEPTH * NBATCH * NMEM * DM;
constexpr size_t O_PP = O_CP + (size_t)DEPTH * NBATCH * 2 * DM;
constexpr size_t O_CS = O_PP + (size_t)DEPTH * NBATCH * 15 * DM;
constexpr size_t O_PSM = O_CS + (size_t)DEPTH * DBATCH * 2 * DM;
constexpr size_t O_END = O_PSM + (size_t)DEPTH * DBATCH * 15 * DM;

constexpr int RING_BYTES = 131072;
constexpr int XTRA_OFF = RING_BYTES, XTRA_BYTES = 8192;
constexpr int MISC_OFF = XTRA_OFF + XTRA_BYTES;
constexpr int LDS_BYTES = 147456;
constexpr int NWAVES = 8;

typedef float f32x2_t __attribute__((ext_vector_type(2)));
typedef __bf16 bf16x2_t __attribute__((ext_vector_type(2)));
__device__ __forceinline__ unsigned cvt_pk_bf16(float lo, float hi) { const f32x2_t v = {lo, hi}; const bf16x2_t b = __builtin_convertvector(v, bf16x2_t); return __builtin_bit_cast(unsigned, b); }
__device__ __forceinline__ float bf_lo(unsigned w) { return __uint_as_float(w << 16); }
__device__ __forceinline__ float bf_hi(unsigned w) { return __uint_as_float(w & 0xffff0000u); }
__device__ __forceinline__ u32x4 pack8(f32x4 a, f32x4 b) { u32x4 w; w.x = cvt_pk_bf16(a[0], a[1]); w.y = cvt_pk_bf16(a[2], a[3]); w.z = cvt_pk_bf16(b[0], b[1]); w.w = cvt_pk_bf16(b[2], b[3]); return w; }
__device__ __forceinline__ u32x2 pack4(f32x4 a) { u32x2 w; w.x = cvt_pk_bf16(a[0], a[1]); w.y = cvt_pk_bf16(a[2], a[3]); return w; }
__device__ __forceinline__ void unpack8(u32x4 w, f32x4& a, f32x4& b) { a = (f32x4){bf_lo(w.x), bf_hi(w.x), bf_lo(w.y), bf_hi(w.y)}; b = (f32x4){bf_lo(w.z), bf_hi(w.z), bf_lo(w.w), bf_hi(w.w)}; }
__device__ __forceinline__ float fast_sigmoid(float x) { return __builtin_amdgcn_rcpf(1.0f + __builtin_amdgcn_exp2f(-LOG2E * x)); }
__device__ __forceinline__ f32x4 sigmoid4(f32x4 v) { return (f32x4){fast_sigmoid(v[0]), fast_sigmoid(v[1]), fast_sigmoid(v[2]), fast_sigmoid(v[3])}; }
__device__ __forceinline__ f32x4 silu4(f32x4 v) { return v * sigmoid4(v); }
__device__ __forceinline__ float wave_sum(float v) {
#pragma unroll
    for (int o = 1; o < 64; o <<= 1) v += __shfl_xor(v, o);
    return v;
}
__device__ __forceinline__ float wave_max(float v) {
#pragma unroll
    for (int o = 1; o < 64; o <<= 1) v = fmaxf(v, __shfl_xor(v, o));
    return v;
}
#define LDS_WAIT() asm volatile("s_waitcnt lgkmcnt(0)" ::: "memory")
#define VM_WAIT() asm volatile("s_waitcnt vmcnt(0)" ::: "memory")

namespace pg8 {
constexpr int BM = 256, BK = 64, HALF = 128, HTB = HALF * BK * 2, STAGE_BYTES = 8 * HTB;
__device__ __forceinline__ int lds_byte(int r, int c) { const int st = (r >> 4) * 2 + (c >> 5), rr = r & 15, cc = c & 31, ob = rr * 64 + cc * 2; return st * 1024 + (ob ^ (((ob >> 9) & 1) << 5)); }
__device__ __forceinline__ void stage_rc(int b, int& R, int& C) { const int st = b / 1024, sb = b % 1024, swz = sb ^ (((sb >> 9) & 1) << 5); R = (st >> 1) * 16 + swz / 64; C = (st & 1) * 32 + (swz % 64) / 2; }
__device__ __forceinline__ int perm32(int rho) { const int n = rho >> 4, i = rho & 15; return 8 * (i >> 2) + 4 * n + (i & 3); }

struct Unit { const char* A; const char* B; int kind, pm, pn, aux; };

template <class Epi, class Sched>
__device__ __forceinline__ void gemm_phase(LAS unsigned char* lds, const int K, const int lda, const int ldb, const Sched& S, const Epi& E) {
    int tid = threadIdx.x; asm volatile("" : "+v"(tid));
    const int wid = __builtin_amdgcn_readfirstlane(tid >> 6), lane = tid & 63, wr = wid >> 2, wc = wid & 3, fr = lane & 15, fq = lane >> 4;
    const int nt = K / BK;
    unsigned voffA[2], voffB[2];
#pragma unroll
    for (int i = 0; i < 2; ++i) { int R, C; stage_rc(tid * 16 + i * 8192, R, C); const int Rb = (R & ~31) + perm32(R & 31);
        voffA[i] = (unsigned)(R * lda + C) * 2u; voffB[i] = (unsigned)(Rb * ldb + C) * 2u; }
    const size_t kstep = (size_t)(BK * 2);
    const size_t hstepA = (size_t)HALF * lda * 2, hstepB = (size_t)HALF * ldb * 2;
    const unsigned ldsw = (unsigned)wid * 1024u;
    const int aoff = lds_byte(wr * 64 + fr, fq * 8), boff = lds_byte(wc * 32 + fr, fq * 8);
#define PG8_SA(b, h) (((b) * 2 + (h)) * HTB)
#define PG8_SB(b, h) ((4 + (b) * 2 + (h)) * HTB)
#define PG8_STAGE(bufoff, gbase, voff) do { _Pragma("unroll") for (int _i = 0; _i < 2; ++_i) \
        __builtin_amdgcn_global_load_lds((const unsigned*)((const char*)(gbase) + (voff)[_i]), (LAS unsigned*)(lds + (bufoff) + ldsw + _i * 8192), 16, 0, 0); } while (0)
#define PG8_LDA(dst, b, h) do { _Pragma("unroll") for (int m = 0; m < 4; ++m) _Pragma("unroll") for (int k = 0; k < 2; ++k) dst[m][k] = *(const LAS bf16x8*)(lds + PG8_SA(b, h) + aoff + m * 2048 + k * 1024); } while (0)
#define PG8_LDB(dst, b, h) do { _Pragma("unroll") for (int n = 0; n < 2; ++n) _Pragma("unroll") for (int k = 0; k < 2; ++k) dst[n][k] = *(const LAS bf16x8*)(lds + PG8_SB(b, h) + boff + n * 2048 + k * 1024); } while (0)
#define PG8_MMA(ai, bj, At, Bt) do { __builtin_amdgcn_s_setprio(1); _Pragma("unroll") for (int m = 0; m < 4; ++m) _Pragma("unroll") for (int n = 0; n < 2; ++n) _Pragma("unroll") for (int k = 0; k < 2; ++k) \
        acc[ai][bj][m][n] = __builtin_amdgcn_mfma_f32_16x16x32_bf16(Bt[n][k], At[m][k], acc[ai][bj][m][n], 0, 0, 0); __builtin_amdgcn_s_setprio(0); } while (0)
#define PG8_WAIT_V(n) asm volatile("s_waitcnt vmcnt(" #n ")" ::: "memory")
#define PG8_WAIT_L(n) asm volatile("s_waitcnt lgkmcnt(" #n ")" ::: "memory")
#define PG8_WAIT_VR(rx) do { if ((rx) >= 16) PG8_WAIT_V(24); else if ((rx) >= 8) PG8_WAIT_V(16); else PG8_WAIT_V(8); } while (0)
#define PG8_BAR __builtin_amdgcn_s_barrier()
#define PG8_SCHED __builtin_amdgcn_sched_barrier(0)
    Unit cur, nxt; int ui = 0, relax = 0;
    if (!S.next(0, cur)) return;
    f32x4 acc[2][2][4][2];
#pragma unroll
    for (int a = 0; a < 2; ++a)
#pragma unroll
        for (int b = 0; b < 2; ++b)
#pragma unroll
            for (int m = 0; m < 4; ++m)
#pragma unroll
                for (int n = 0; n < 2; ++n) acc[a][b][m][n] = (f32x4){0.f, 0.f, 0.f, 0.f};
    bf16x8 At[4][2], B0[2][2], B1[2][2];
    const char* cA = cur.A; const char* cB = cur.B;
    E.prefetch(cur, 0, lds, wid, lane);
    PG8_STAGE(PG8_SB(0, 0), cB, voffB); PG8_STAGE(PG8_SB(0, 1), cB + hstepB, voffB); PG8_STAGE(PG8_SA(0, 0), cA, voffA); PG8_STAGE(PG8_SA(0, 1), cA + hstepA, voffA);
    if (wr == 1) PG8_BAR;
    PG8_WAIT_V(2); PG8_BAR;
    PG8_STAGE(PG8_SB(1, 0), cB + kstep, voffB); PG8_STAGE(PG8_SA(1, 0), cA + kstep, voffA); PG8_STAGE(PG8_SB(1, 1), cB + hstepB + kstep, voffB);
    PG8_WAIT_V(6); PG8_BAR;
    for (;;) {
        const bool has_next = S.next(ui + 1, nxt);
        const char* nA = has_next ? nxt.A : cA; const char* nB = has_next ? nxt.B : cB;
#pragma nounroll
        for (int t = 0; t < nt; t += 2) {
            const bool last = (t == nt - 2); const int rx = (t == 0) ? relax : 0;
            const char* a1 = cA + (size_t)(t + 1) * kstep;
            const char* a2 = last ? nA : cA + (size_t)(t + 2) * kstep; const char* b2 = last ? nB : cB + (size_t)(t + 2) * kstep;
            const char* a3 = a2 + kstep; const char* b3 = b2 + kstep;
            PG8_LDB(B0, 0, 0); PG8_LDB(B1, 0, 1); PG8_SCHED; PG8_LDA(At, 0, 0); PG8_STAGE(PG8_SA(1, 1), a1 + hstepA, voffA);
            PG8_WAIT_VR(rx); PG8_WAIT_L(0); PG8_BAR; PG8_MMA(0, 0, At, B0); PG8_MMA(0, 1, At, B1); PG8_BAR; PG8_SCHED;
            PG8_LDA(At, 0, 1); PG8_STAGE(PG8_SB(0, 0), b2, voffB); PG8_STAGE(PG8_SB(0, 1), b2 + hstepB, voffB); PG8_STAGE(PG8_SA(0, 0), a2, voffA);
            PG8_WAIT_VR(rx); PG8_WAIT_L(0); PG8_BAR; PG8_MMA(1, 0, At, B0); PG8_MMA(1, 1, At, B1); PG8_BAR; PG8_SCHED;
            PG8_LDB(B0, 1, 0); PG8_LDB(B1, 1, 1); PG8_SCHED; PG8_LDA(At, 1, 0); PG8_STAGE(PG8_SA(0, 1), a2 + hstepA, voffA);
            PG8_WAIT_V(8); PG8_WAIT_L(0); PG8_BAR; PG8_MMA(0, 0, At, B0); PG8_MMA(0, 1, At, B1); PG8_BAR; PG8_SCHED;
            PG8_LDA(At, 1, 1); PG8_STAGE(PG8_SB(1, 0), b3, voffB); PG8_STAGE(PG8_SB(1, 1), b3 + hstepB, voffB); PG8_STAGE(PG8_SA(1, 0), a3, voffA);
            PG8_WAIT_V(8); PG8_WAIT_L(0); PG8_BAR; PG8_MMA(1, 0, At, B0); PG8_MMA(1, 1, At, B1); PG8_BAR; PG8_SCHED;
        }
        if (wr == 0) PG8_BAR;
        E(acc, cur, wr, wc, fr, fq, lds, ui);
        if (!has_next) break;
        if (!E.keep_acc(cur)) {
#pragma unroll
        for (int a = 0; a < 2; ++a)
#pragma unroll
            for (int b = 0; b < 2; ++b)
#pragma unroll
                for (int m = 0; m < 4; ++m)
#pragma unroll
                    for (int n = 0; n < 2; ++n) acc[a][b][m][n] = (f32x4){0.f, 0.f, 0.f, 0.f};
        }
        relax = E.stores_lb(cur);
        cur = nxt; cA = nA; cB = nB; ++ui;
        E.prefetch(cur, ui, lds, wid, lane);
        if (wr == 1) PG8_BAR;
    }
    PG8_WAIT_V(0);
    PG8_BAR;
#undef PG8_SA
#undef PG8_SB
#undef PG8_STAGE
#undef PG8_LDA
#undef PG8_LDB
#undef PG8_MMA
#undef PG8_WAIT_V
#undef PG8_WAIT_L
#undef PG8_WAIT_VR
#undef PG8_BAR
#undef PG8_SCHED
}
template <int WGM = 8> __device__ __forceinline__ void tile_remap(int L, int nM, int nN, int& pm, int& pn) {
    const int nwg = nM * nN; int wgid = L;
    { const int q = nwg / 8, r = nwg % 8, xcd = wgid % 8, off = wgid / 8; wgid = (xcd < r ? xcd * (q + 1) : r * (q + 1) + (xcd - r) * q) + off; }
    const int nig = WGM * nN, gid = wgid / nig, fm = gid * WGM, gsz = (nM - fm) < WGM ? (nM - fm) : WGM;
    pm = fm + ((wgid % nig) % gsz); pn = (wgid % nig) / gsz;
}
}

#define XB_TMO      128
#define XB_XCNT(j)  (256  + 64 * (j))
#define XB_XSUB(j)  (1280 + 64 * (j))
#define XB_XGEN(j)  (2304 + 64 * (j))
#define XB_TOP      3328
#define XB_TOPGEN   3392
#define XCD_BAR_WORDS 3456
#define XB_SPIN_CAP (1u << 18)
__device__ __forceinline__ unsigned xb_ld(unsigned* p)              { return __hip_atomic_load(p, __ATOMIC_RELAXED, __HIP_MEMORY_SCOPE_AGENT); }
__device__ __forceinline__ unsigned xb_add(unsigned* p, unsigned v) { return __hip_atomic_fetch_add(p, v, __ATOMIC_RELAXED, __HIP_MEMORY_SCOPE_AGENT); }
__device__ __forceinline__ unsigned xb_xcc_id() { return (unsigned)__builtin_amdgcn_s_getreg((3 << 11) | 20) & 0xFu; }
#define XB_SPIN(cond, bar) do { unsigned _sp = 0; while (cond) { __builtin_amdgcn_s_sleep(1); \
    if ((++_sp & 255u) == 0u) { if (xb_ld(&(bar)[XB_TMO])) break; if (_sp > XB_SPIN_CAP) { atomicAdd(&(bar)[XB_TMO], 1u); break; } } } } while (0)
struct XcdBarrier { unsigned* bar; unsigned x; volatile LAS unsigned* st; };
__device__ __forceinline__ XcdBarrier xcd_barrier_post(unsigned* bar, volatile LAS unsigned* st) {
    XcdBarrier b; b.bar = bar; b.x = xb_xcc_id(); b.st = st;
    if (threadIdx.x == 0) (void)xb_add(&bar[XB_XCNT(b.x)], 1u);
    return b;
}
__device__ __forceinline__ void xcd_barrier_complete(unsigned* bar, unsigned x, unsigned& nloc, unsigned& nx) {
    const unsigned G = gridDim.x * gridDim.y * gridDim.z;
    unsigned sum, cnt, mine, sp = 0u;
    for (;;) {
        sum = 0u; cnt = 0u; mine = 0u;
#pragma unroll
        for (unsigned j = 0; j < 16; ++j) { const unsigned c = xb_ld(&bar[XB_XCNT(j)]); sum += c; cnt += (c > 0u) ? 1u : 0u; mine = (j == x) ? c : mine; }
        if (sum == G) break;
        __builtin_amdgcn_s_sleep(1);
        if ((++sp & 255u) == 0u) { if (xb_ld(&bar[XB_TMO])) break; if (sp > XB_SPIN_CAP) { atomicAdd(&bar[XB_TMO], 1u); break; } }
    }
    nloc = mine > 0u ? mine : 1u; nx = cnt > 0u ? cnt : 1u;
}
__device__ __forceinline__ void xcd_barrier(const XcdBarrier& b) {
    asm volatile("s_waitcnt vmcnt(0)" ::: "memory");
    __syncthreads();
    if (threadIdx.x == 0) {
        unsigned* bar = b.bar;
        __builtin_amdgcn_s_waitcnt(0);
        unsigned nloc = b.st[0], nx = b.st[1];
        if (nloc == 0u) { xcd_barrier_complete(bar, b.x, nloc, nx); b.st[0] = nloc; b.st[1] = nx; }
        const unsigned old = xb_add(&bar[XB_XSUB(b.x)], 1u);
        const unsigned gen = old / nloc;
        if (old + 1u == (gen + 1u) * nloc) {
            __builtin_amdgcn_fence(__ATOMIC_RELEASE, "agent");
            asm volatile("s_waitcnt vmcnt(0)" ::: "memory");
            const unsigned og = xb_add(&bar[XB_TOP], 1u);
            const unsigned tg = og / nx;
            if (og + 1u == (tg + 1u) * nx) xb_add(&bar[XB_TOPGEN], 1u);
            else XB_SPIN(xb_ld(&bar[XB_TOPGEN]) == tg, bar);
            __builtin_amdgcn_fence(__ATOMIC_ACQUIRE, "agent");
            xb_add(&bar[XB_XGEN(b.x)], 1u);
            asm volatile("s_waitcnt vmcnt(0)" ::: "memory");
        } else {
            XB_SPIN(xb_ld(&bar[XB_XGEN(b.x)]) == gen, bar);
            __builtin_amdgcn_fence(__ATOMIC_ACQUIRE, "agent");
            asm volatile("s_waitcnt vmcnt(0)" ::: "memory");
        }
    }
    __syncthreads();
}

struct Args { const float* in[19]; float* out; unsigned char* ws; };
enum In { I_XP = 0, I_XS, I_MEM, I_CK, I_CV, I_SCONV, I_SPOOL, I_NG, I_WIN, I_CONVW, I_POOLW, I_PSCALE, I_MNG, I_WKV, I_WBC, I_WBP, I_WBA, I_WOUT, I_FNG };
enum Kind { K_Z = 0, K_KV, K_VT, K_S, K_O, K_POOL, K_BR, K_OUT };

struct Ctx {
    const float* in[19]; float* out; unsigned char* ws;
    LAS unsigned char* lds;
    int tid, lane, wave, G, c, vcu;
    __device__ __forceinline__ bf16_t* z(int slot) const { return (bf16_t*)(ws + WS_Z + (size_t)slot * SLOT); }
    __device__ __forceinline__ float* rss(int i) const { return (float*)(ws + WS_CTL) + CW_RSS + i * 32768; }
};

__device__ __forceinline__ int win_src_col(int np) {
    const int tile = np >> 8, i = np & 255;
    if (tile < 8) return (i < 128) ? (128 * tile + i) : (2 * DM + 128 * tile + (i - 128));
    if (tile < 16) { const int p = tile - 8; return (i < 128) ? (DM + 128 * p + i) : (3 * DM + 128 * p + (i - 128)); }
    return np;
}

__device__ __forceinline__ int gate_dst_row(int sel, int c) {
    const int t = c >> 6, wc = (c >> 4) & 3, fq = (c >> 2) & 3, j = c & 3;
    const int bj = (sel == 0 || sel == 3) ? 1 : 0, n = (sel == 0 || sel == 2) ? 1 : 0;
    return 256 * (28 + t) + 128 * bj + 32 * wc + 8 * fq + 4 * n + j;
}
template <bool SCALE = false, bool GATE = false>
__device__ __forceinline__ void p0_transpose_item(const float* W, int ldw, int srccol0, int k0, bf16_t* WT, int ldt, int dstrow0, LAS float* scr, int lane, const float* gk = nullptr, int gsel = 0) {
    f32x4 wv[8];
#pragma unroll
    for (int i = 0; i < 8; ++i) wv[i] = *(const f32x4*)(W + (size_t)(k0 + 8 * i + (lane >> 3)) * ldw + srccol0 + 4 * (lane & 7));
    if constexpr (SCALE) { float gv[8];
#pragma unroll
        for (int i = 0; i < 8; ++i) gv[i] = gk[k0 + 8 * i + (lane >> 3)];
#pragma unroll
        for (int i = 0; i < 8; ++i) wv[i] *= gv[i]; }
#pragma unroll
    for (int i = 0; i < 8; ++i)
#pragma unroll
        for (int e = 0; e < 4; ++e) scr[(8 * i + (lane >> 3)) * 33 + 4 * (lane & 7) + e] = wv[i][e];
    LDS_WAIT(); asm volatile("" ::: "memory");
    const int c = lane & 7;
#pragma unroll
    for (int j = 0; j < 4; ++j) { const int n = (lane >> 3) + 8 * j; const LAS float* s = scr + (8 * c) * 33 + n;
        u32x4 o; o.x = cvt_pk_bf16(s[0 * 33], s[1 * 33]); o.y = cvt_pk_bf16(s[2 * 33], s[3 * 33]); o.z = cvt_pk_bf16(s[4 * 33], s[5 * 33]); o.w = cvt_pk_bf16(s[6 * 33], s[7 * 33]);
        const int drow = GATE ? gate_dst_row(gsel, dstrow0 + n) : dstrow0 + n;
        *(u32x4*)(WT + (size_t)drow * ldt + k0 + 8 * c) = o; }
    LDS_WAIT(); asm volatile("" ::: "memory");
}

constexpr int XI_LATE = 16 * (DIN / 32) + 16 * 64;
constexpr int XI_IN = 16 * (DIN / 32), XI_KV = 16 * 64, XI_BR = 16 * 32, XI_PWG = 4 * 8, XI_PER_LAYER = XI_IN + XI_KV + 4 * XI_BR + 4 * XI_PWG;
__device__ __forceinline__ void convert_weights(const Ctx& F, int item0, int item1, int gw, int NGW) {
    LAS float* scr = (LAS float*)(F.lds + F.wave * 16384);
    int lane = F.lane; asm volatile("" : "+v"(lane));
    gw = __builtin_amdgcn_readfirstlane(gw); asm volatile("" : "+s"(gw));
    constexpr int I_IN = XI_IN, I_KV = XI_KV, I_BR = XI_BR, I_PWG = XI_PWG, PER_LAYER = XI_PER_LAYER;
    struct XItem { const float* W; bf16_t* WT; const float* gk; int ldw, ldt, dstrow0, gsel; };
    auto decode = [&](int it, XItem& X) -> bool {
        if (it >= item1) return false;
        const int l = it / PER_LAYER; int r = it % PER_LAYER;
        X.gk = nullptr; X.gsel = -1; X.ldt = DM;
        if (r < I_IN) { const int kb = r / (DIN / 32), nb = r % (DIN / 32); const float* Wl = F.in[I_WIN] + (size_t)l * DM * DIN + (size_t)(64 * kb) * DIN;
            X.ldw = DIN; X.gk = F.in[I_NG] + (size_t)l * DM + 64 * kb; X.WT = (bf16_t*)(F.ws + WS_WIN) + (size_t)l * DIN * DM + 64 * kb;
            if (nb >= 7168 / 32) { const int sc = 32 * nb - 7168; X.W = Wl + 32 * nb; X.dstrow0 = sc & 1023; X.gsel = sc >> 10; }
            else { X.W = Wl + win_src_col(32 * nb); X.dstrow0 = 32 * nb; }
            return true; }
        r -= I_IN;
        if (r < I_KV) { const int kb = r / 64, nb = r % 64; X.ldw = 2048; X.W = F.in[I_WKV] + (size_t)l * DM * 2048 + (size_t)(64 * kb) * 2048 + 32 * nb; X.WT = (bf16_t*)(F.ws + WS_WKV) + (size_t)l * 2048 * DM + 64 * kb; X.dstrow0 = 32 * nb; return true; }
        r -= I_KV;
        if (r < 4 * I_BR) { const int wsel = r / I_BR, rr = r % I_BR, kb = rr / 32, nb = rr % 32; X.ldw = DM;
            const float* Wb; bf16_t* Tb;
            if (wsel == 0) { Wb = F.in[I_WBC]; Tb = (bf16_t*)(F.ws + WS_WBR) + ((size_t)l * 3 + 0) * DM * DM; }
            else if (wsel == 1) { Wb = F.in[I_WBP]; Tb = (bf16_t*)(F.ws + WS_WBR) + ((size_t)l * 3 + 1) * DM * DM; }
            else if (wsel == 2) { Wb = F.in[I_WBA]; Tb = (bf16_t*)(F.ws + WS_WBR) + ((size_t)l * 3 + 2) * DM * DM; }
            else { Wb = F.in[I_WOUT]; Tb = (bf16_t*)(F.ws + WS_WO) + (size_t)l * DM * DM; }
            X.W = Wb + (size_t)l * DM * DM + (size_t)(64 * kb) * DM + 32 * nb; X.WT = Tb + 64 * kb; X.dstrow0 = 32 * nb; return true; }
        r -= 4 * I_BR;
        { const int g = r / I_PWG, rr = r % I_PWG, kb = rr / 8, nb = rr % 8;
          X.ldw = 256; X.ldt = 256; X.W = F.in[I_POOLW] + ((size_t)l * 4 + g) * 256 * 256 + (size_t)(64 * kb) * 256 + 32 * nb; X.WT = (bf16_t*)(F.ws + WS_PW) + ((size_t)l * 4 + g) * 256 * 256 + 64 * kb; X.dstrow0 = 32 * nb; }
        return true;
    };
    auto xload = [&](const XItem& X, f32x4 (&wv)[8], float (&gv)[8]) {
#pragma unroll
        for (int i = 0; i < 8; ++i) wv[i] = *(const f32x4*)(X.W + (size_t)(8 * i + (lane >> 3)) * X.ldw + 4 * (lane & 7));
#pragma unroll
        for (int i = 0; i < 8; ++i) gv[i] = X.gk ? X.gk[8 * i + (lane >> 3)] : 1.0f;
    };
    auto xfinish = [&](const XItem& X, const f32x4 (&wv)[8], const float (&gv)[8]) {
#pragma unroll
        for (int i = 0; i < 8; ++i)
#pragma unroll
            for (int e = 0; e < 4; ++e) scr[(8 * i + (lane >> 3)) * 33 + 4 * (lane & 7) + e] = wv[i][e] * gv[i];
        LDS_WAIT(); asm volatile("" ::: "memory");
        const int c = lane & 7;
#pragma unroll
        for (int j = 0; j < 4; ++j) { const int n = (lane >> 3) + 8 * j; const LAS float* s = scr + (8 * c) * 33 + n;
            u32x4 o; o.x = cvt_pk_bf16(s[0 * 33], s[1 * 33]); o.y = cvt_pk_bf16(s[2 * 33], s[3 * 33]); o.z = cvt_pk_bf16(s[4 * 33], s[5 * 33]); o.w = cvt_pk_bf16(s[6 * 33], s[7 * 33]);
            const int drow = (X.gsel >= 0) ? gate_dst_row(X.gsel, X.dstrow0 + n) : X.dstrow0 + n;
            *(u32x4*)(X.WT + (size_t)drow * X.ldt + 8 * c) = o; }
        LDS_WAIT(); asm volatile("" ::: "memory");
    };
    {
        XItem cur, nxt; f32x4 wv[8], wn[8]; float gv[8], gn[8];
        int it = item0 + gw; bool has = decode(it, cur);
        if (has) xload(cur, wv, gv);
        while (has) {
            it += NGW;
            const bool hn = decode(it, nxt);
            if (hn) xload(nxt, wn, gn);
            __builtin_amdgcn_sched_barrier(0);
            xfinish(cur, wv, gv);
            cur = nxt; has = hn;
#pragma unroll
            for (int i = 0; i < 8; ++i) { wv[i] = wn[i]; gv[i] = gn[i]; }
        }
    }
}

__device__ __forceinline__ void p0_prologue(const Ctx& F) {
    LAS float* scr = (LAS float*)(F.lds + F.wave * 16384);
    const int gw = F.vcu * NWAVES + F.wave, NGW = F.G * NWAVES, lane = F.lane;
    convert_weights(F, 0, XI_PER_LAYER, gw, NGW);
#pragma nounroll
    for (int l = 1; l < DEPTH; ++l) convert_weights(F, l * XI_PER_LAYER + XI_LATE, (l + 1) * XI_PER_LAYER, gw, NGW);
    {
        float* rss0 = F.rss(0);
        for (int m0 = 4 * gw; m0 < MT; m0 += 4 * NGW) {
            f32x4 v[4][4];
#pragma unroll
            for (int r = 0; r < 4; ++r) { const int m = m0 + r;
                const f32x4* xr = (const f32x4*)((m < MP) ? F.in[I_XP] + (size_t)m * DM : F.in[I_XS] + (size_t)(m - MP) * DM) + lane;
#pragma unroll
                for (int j = 0; j < 4; ++j) v[r][j] = xr[64 * j]; }
#pragma unroll
            for (int r = 0; r < 4; ++r) { const int m = m0 + r; float s = 0.f;
#pragma unroll
                for (int j = 0; j < 4; ++j) s += (v[r][j].x * v[r][j].x + v[r][j].y * v[r][j].y) + (v[r][j].z * v[r][j].z + v[r][j].w * v[r][j].w);
                s = wave_sum(s);
                if (lane == 0) rss0[m] = s;
                u32x2* o8 = (u32x2*)((bf16_t*)(F.ws + WS_XG) + (size_t)m * DM) + lane;
#pragma unroll
                for (int j = 0; j < 4; ++j) { const f32x4 y = v[r][j]; u32x2 w; w.x = cvt_pk_bf16(y.x, y.y); w.y = cvt_pk_bf16(y.z, y.w); o8[64 * j] = w; } }
        }
    }
    for (int m = gw; m < NBATCH * NMEM; m += NGW) {
        const f32x4* xr = (const f32x4*)(F.in[I_MEM] + (size_t)m * DM) + lane;
        f32x4 v[4], g0[4], g1[4]; float s = 0.f;
#pragma unroll
        for (int j = 0; j < 4; ++j) { v[j] = xr[64 * j]; g0[j] = ((const f32x4*)F.in[I_MNG] + lane)[64 * j]; g1[j] = ((const f32x4*)(F.in[I_MNG] + DM) + lane)[64 * j]; }
#pragma unroll
        for (int j = 0; j < 4; ++j) s += (v[j].x * v[j].x + v[j].y * v[j].y) + (v[j].z * v[j].z + v[j].w * v[j].w);
        const float rstd = rsqrtf(wave_sum(s) * (1.f / DM) + EPS);
        u32x2* o0 = (u32x2*)((bf16_t*)(F.ws + WS_HM) + (size_t)m * DM) + lane;
        u32x2* o1 = (u32x2*)((bf16_t*)(F.ws + WS_HM) + ((size_t)NBATCH * NMEM + m) * DM) + lane;
#pragma unroll
        for (int j = 0; j < 4; ++j) { const f32x4 y0 = v[j] * rstd * g0[j], y1 = v[j] * rstd * g1[j]; u32x2 w;
            w.x = cvt_pk_bf16(y0.x, y0.y); w.y = cvt_pk_bf16(y0.z, y0.w); o0[64 * j] = w; w.x = cvt_pk_bf16(y1.x, y1.y); w.y = cvt_pk_bf16(y1.z, y1.w); o1[64 * j] = w; }
    }
    {
        const size_t n4 = (size_t)DEPTH * DBATCH * 11 * (DM / 4), st = (size_t)F.G * 512;
        for (size_t i0 = (size_t)F.vcu * 512 + F.tid; i0 < n4; i0 += 4 * st) {
            f32x4 v[4];
#pragma unroll
            for (int q = 0; q < 4; ++q) { const size_t i = i0 + q * st; if (i < n4) { const size_t c4 = i % (DM / 4), rowi = i / (DM / 4), k = rowi % 11, lb = rowi / 11; v[q] = ((const f32x4*)F.in[I_SPOOL])[(lb * 15 + 4 + k) * (DM / 4) + c4]; } }
#pragma unroll
            for (int q = 0; q < 4; ++q) { const size_t i = i0 + q * st; if (i < n4) { const size_t c4 = i % (DM / 4), rowi = i / (DM / 4), k = rowi % 11, lb = rowi / 11; ((f32x4*)(F.out + O_PSM))[(lb * 15 + k) * (DM / 4) + c4] = v[q]; } }
        }
    }
}

constexpr size_t TILEB = (size_t)256 * DM * 2;
struct SchedP1 {
    int G, c; const char *XG, *WinT, *HM, *WkvT;
    __device__ __forceinline__ bool next(int i, pg8::Unit& u) const {
        const int L0 = i * G + c;
        if (L0 >= 3000) return false;
        const int L = (L0 < 96) ? 2904 + L0 : L0 - 96;
        if (L < 2904) { int pm, pn; pg8::tile_remap<6>(L, 66, 44, pm, pn); pn = 43 - pn;        u.kind = K_Z; u.pm = pm; u.pn = pn; u.aux = 0; u.A = XG + (size_t)pm * TILEB; u.B = WinT + (size_t)pn * TILEB; return true; }
        if (L < 2968) { const int t = L - 2904; u.kind = K_KV; u.pm = t >> 3; u.pn = t & 7; u.aux = 0; u.A = HM + (size_t)u.pm * TILEB; u.B = WkvT + (size_t)u.pn * TILEB; return true; }
        if (L < 3000) { const int t = L - 2968; u.kind = K_VT; u.pm = t >> 3; u.pn = t & 7; u.aux = 0; u.A = WkvT + (size_t)(4 + u.pm) * TILEB; u.B = HM + (size_t)u.pn * TILEB; return true; }
        return false;
    }
};
struct SchedP2 {
    int G, c; const char *Q, *KB, *PS, *VT, *MIX, *PwT;
    __device__ __forceinline__ bool next(int i, pg8::Unit& u) const {
        const int r = i / 3, ph = i - 3 * r, L = r * G + c; if (L >= 256) return false;
        const int b = L & 7, idx = L >> 3, j = idx & 7, h = idx >> 3;
        if (ph == 1) { u.kind = K_POOL; u.pm = L >> 2; u.pn = L & 3; u.aux = 0;
            u.A = MIX + ((size_t)u.pm * 256 * DM + 256 * u.pn) * 2; u.B = PwT + (size_t)u.pn * 256 * 256 * 2; return true; }
        u.pm = b * 8 + j; u.pn = h; u.aux = 0;
        if (ph == 0) { u.kind = K_S; u.A = Q + ((size_t)u.pm * 256 * DM + 256 * h) * 2; u.B = KB + ((size_t)(b * NHEAD + h) * NMEM * HDIM) * 2; }
        else { u.kind = K_O; u.A = PS + ((size_t)u.pm * 256 * DM + 256 * h) * 2; u.B = VT + ((size_t)b * DM * 256 + (size_t)256 * h * 256) * 2; }
        return true;
    }
};
struct SchedP3 {
    int G, c; const char *AC, *Wbr;
    __device__ __forceinline__ bool next(int i, pg8::Unit& u) const {
        const int tr = i / 3, br = i - 3 * tr, L = tr * G + c; if (L >= 256) return false;
        int pm, pn; pg8::tile_remap(L, 64, 4, pm, pn); u.kind = K_BR; u.pm = pm; u.pn = pn; u.aux = br;
        u.A = AC + (size_t)br * SLOT + (size_t)pm * TILEB; u.B = Wbr + ((size_t)br * DM + 256 * pn) * DM * 2; return true;
    }
};
struct SchedP4 {
    int G, c; const char *MRG, *Wo;
    __device__ __forceinline__ bool next(int i, pg8::Unit& u) const {
        const int L = i * G + c; if (L >= 256) return false;
        int pm, pn; pg8::tile_remap(L, 64, 4, pm, pn); u.kind = K_OUT; u.pm = pm; u.pn = pn; u.aux = 0;
        u.A = MRG + (size_t)pm * TILEB; u.B = Wo + (size_t)pn * TILEB; return true;
    }
};

#define GP(T, base, off) ((T*)((char*)(base) + (unsigned)(off)))
#define GPC(T, base, off) ((const T*)((const char*)(base) + (unsigned)(off)))
template <int PH> struct Epi {
    __device__ __forceinline__ bool keep_acc(const pg8::Unit& u) const { return PH == 4 && u.aux < 2; }
    Ctx F; int l; int rep = 0;
    __device__ __forceinline__ int stores_lb(const pg8::Unit& u) const {
        if constexpr (PH == 1) { if (u.kind == K_Z) return (u.pn < 16) ? 8 : ((u.pm >= 64 && u.pn >= 24 && u.pn < 32) ? 0 : 16); return 16; }
        return 0;
    }
    __device__ __forceinline__ void prefetch(const pg8::Unit& u, int ui, LAS unsigned char* lds, int wid, int lane) const {
        if constexpr (PH == 1) {
            if (u.kind == K_Z && wid == 0) {
                const float* rss = F.rss(l) + u.pm * 256 + lane;
#pragma unroll
                for (int i = 0; i < 4; ++i) __builtin_amdgcn_global_load_lds((const unsigned*)(rss + 64 * i), (LAS unsigned*)(lds + XTRA_OFF + (ui & 1) * 1024 + i * 256), 4, 0, 0);
            }
        }
    }
    __device__ __forceinline__ void operator()(f32x4 (&acc)[2][2][4][2], const pg8::Unit& u, int wr, int wc, int fr, int fq, LAS unsigned char* lds, int ui) const {
        unsigned rl = (unsigned)(wr * 64 + fr), cl = (unsigned)(wc * 32 + 8 * fq);
        asm volatile("" : "+v"(rl), "+v"(cl));
        const unsigned lo2 = (rl * DM + cl) * 2u, lo4 = (rl * DM + cl) * 4u;
        constexpr unsigned RS2 = 16u * DM * 2u, AS2 = 128u * DM * 2u, RS4 = 16u * DM * 4u, AS4 = 128u * DM * 4u;
        if constexpr (PH == 1) {
            if (u.kind == K_Z) {
                const unsigned row0 = (unsigned)u.pm * 256u + rl;
                float rsv[2][4];
                const LAS float* rsl = (const LAS float*)(lds + XTRA_OFF + (ui & 1) * 1024);
#pragma unroll
                for (int ai = 0; ai < 2; ++ai)
#pragma unroll
                    for (int m = 0; m < 4; ++m) rsv[ai][m] = rsl[rl + 128 * ai + 16 * m];
#pragma unroll
                for (int ai = 0; ai < 2; ++ai)
#pragma unroll
                    for (int m = 0; m < 4; ++m) rsv[ai][m] = rsqrtf(rsv[ai][m] * (1.f / DM) + EPS);
                if (u.pn < 8) {
                    const int p = u.pn;
                    char* dst = (char*)(F.z(Z_U) + (size_t)u.pm * 256 * DM + 128 * p);
#pragma unroll
                    for (int ai = 0; ai < 2; ++ai)
#pragma unroll
                        for (int m = 0; m < 4; ++m) {
                            const float rs2 = rsv[ai][m] * rsv[ai][m];
                            const f32x4 o0 = acc[ai][0][m][0] * acc[ai][1][m][0] * rs2, o1 = acc[ai][0][m][1] * acc[ai][1][m][1] * rs2;
                            *GP(u32x4, dst, lo2 + ai * AS2 + m * RS2) = pack8(o0, o1);
                            const unsigned row = row0 + 128 * ai + 16 * m; unsigned oo = 0xffffffffu;
                            if (row < (unsigned)MP) { const unsigned t = row & (SEQ - 1); if (t >= SEQ - 2) oo = (unsigned)(O_CP + (((size_t)l * NBATCH + (row >> 11)) * 2 + (t - (SEQ - 2))) * DM); }
                            else { const unsigned rs_ = row - MP, t = rs_ & 3; if (t >= 2) oo = (unsigned)(O_CS + (((size_t)l * DBATCH + (rs_ >> 2)) * 2 + (t - 2)) * DM); }
                            if (oo != 0xffffffffu) { oo = (oo + 128 * p + cl) * 4u; *GP(f32x4, F.out, oo) = o0; *GP(f32x4, F.out, oo + 16) = o1; }
                            asm volatile("" ::: "memory");
                        }
                } else if (u.pn < 16) {
                    const int p = u.pn - 8;
                    char* dst = (char*)(F.z(Z_BS) + (size_t)u.pm * 256 * DM + 128 * p);
#pragma unroll
                    for (int ai = 0; ai < 2; ++ai)
#pragma unroll
                        for (int m = 0; m < 4; ++m) {
                            const float rs2 = rsv[ai][m] * rsv[ai][m], nrs = -LOG2E * rsv[ai][m];
                            f32x4 o[2];
#pragma unroll
                            for (int n = 0; n < 2; ++n)
#pragma unroll
                                for (int j = 0; j < 4; ++j) { const float g = acc[ai][1][m][n][j]; o[n][j] = (acc[ai][0][m][n][j] * g * rs2) * __builtin_amdgcn_rcpf(1.0f + __builtin_amdgcn_exp2f(g * nrs)); }
                            *GP(u32x4, dst, lo2 + ai * AS2 + m * RS2) = pack8(o[0], o[1]);
                            asm volatile("" ::: "memory");
                        }
                } else if (u.pn >= 28) {
                    char* dc = (char*)(F.z(Z_SMC) + (size_t)u.pm * 256 * DM + 64 * (u.pn - 28));
                    const unsigned odd = (cl >> 3) & 1u, lom = rl * (DM * 2u) + (cl & ~8u);
                    const unsigned o0 = lom + odd * (unsigned)SLOT, o1 = lom + (1u - odd) * (unsigned)(3 * SLOT);
#pragma unroll
                    for (int ai = 0; ai < 2; ++ai)
#pragma unroll
                        for (int m = 0; m < 4; ++m) {
                            const float rs = rsv[ai][m], nrs = -LOG2E * rs;
                            f32x4 r1, r2, ga, sg;
#pragma unroll
                            for (int j = 0; j < 4; ++j) {
                                const float ec = 1.0f + __builtin_amdgcn_exp2f(fminf(acc[ai][0][m][0][j] * nrs, 60.f)), ep = 1.0f + __builtin_amdgcn_exp2f(fminf(acc[ai][0][m][1][j] * nrs, 60.f));
                                const float ea = 1.0f + __builtin_amdgcn_exp2f(fminf(acc[ai][1][m][0][j] * nrs, 60.f)), zs = acc[ai][1][m][1][j];
                                const float ip = __builtin_amdgcn_rcpf(ep); ga[j] = __builtin_amdgcn_rcpf(ea);
                                r1[j] = ep * __builtin_amdgcn_rcpf(ec); r2[j] = ea * ip; sg[j] = (zs * rs) * __builtin_amdgcn_rcpf(1.0f + __builtin_amdgcn_exp2f(zs * nrs)); }
                            const u32x2 p1 = pack4(r1), p2 = pack4(r2), pa = pack4(ga), ps = pack4(sg);
                            const auto s0 = __builtin_amdgcn_permlane16_swap(p1.x, p2.x, false, false), s1 = __builtin_amdgcn_permlane16_swap(p1.y, p2.y, false, false);
                            const auto s2 = __builtin_amdgcn_permlane16_swap(pa.x, ps.x, false, false), s3 = __builtin_amdgcn_permlane16_swap(pa.y, ps.y, false, false);
                            *GP(u32x4, dc, o0 + ai * AS2 + m * RS2) = (u32x4){s0[0], s1[0], s0[1], s1[1]};
                            *GP(u32x4, dc - SLOT, o1 + ai * AS2 + m * RS2) = (u32x4){s2[0], s3[0], s2[1], s3[1]};
                            asm volatile("" ::: "memory");
                        }
                } else {
                    const int slot = Z_HP + ((u.pn - 16) >> 2), cb = 256 * ((u.pn - 16) & 3);
                    char* dst = (char*)(F.z(slot) + (size_t)u.pm * 256 * DM + cb);
                    if (slot == Z_HP) {
#pragma unroll
                        for (int ai = 0; ai < 2; ++ai)
#pragma unroll
                            for (int m = 0; m < 4; ++m) {
                                const float rs = rsv[ai][m];
                                const unsigned row = row0 + 128 * ai + 16 * m; unsigned oo = 0xffffffffu;
                                if (row < (unsigned)MP) { const unsigned t = row & (SEQ - 1); if (t >= SEQ - 15) oo = (unsigned)(O_PP + (((size_t)l * NBATCH + (row >> 11)) * 15 + (t - (SEQ - 15))) * DM); }
                                else { const unsigned rs_ = row - MP; oo = (unsigned)(O_PSM + (((size_t)l * DBATCH + (rs_ >> 2)) * 15 + 11 + (rs_ & 3)) * DM); }
                                if (oo != 0xffffffffu) oo = (oo + cb + cl) * 4u;
#pragma unroll
                                for (int bj = 0; bj < 2; ++bj) {
                                    const f32x4 v0 = acc[ai][bj][m][0] * rs, v1 = acc[ai][bj][m][1] * rs;
                                    if (oo != 0xffffffffu) { *GP(f32x4, F.out, oo + 512 * bj) = v0; *GP(f32x4, F.out, oo + 512 * bj + 16) = v1; }
                                    *GP(u32x4, dst, lo2 + ai * AS2 + m * RS2 + 256 * bj) = pack8(v0, v1);
                                }
                                asm volatile("" ::: "memory");
                            }
                    } else if (slot == Z_Q) {
#pragma unroll
                        for (int ai = 0; ai < 2; ++ai)
#pragma unroll
                            for (int m = 0; m < 4; ++m) {
                                const float rs = rsv[ai][m] * 0.0625f;
#pragma unroll
                                for (int bj = 0; bj < 2; ++bj) *GP(u32x4, dst, lo2 + ai * AS2 + m * RS2 + 256 * bj) = pack8(acc[ai][bj][m][0] * rs, acc[ai][bj][m][1] * rs);
                                asm volatile("" ::: "memory");
                            }
                    } else {
#pragma unroll
                        for (int ai = 0; ai < 2; ++ai)
#pragma unroll
                            for (int m = 0; m < 4; ++m) {
                                const float rs = rsv[ai][m], nrs = -LOG2E * rs;
#pragma unroll
                                for (int bj = 0; bj < 2; ++bj) { f32x4 o[2];
#pragma unroll
                                    for (int n = 0; n < 2; ++n)
#pragma unroll
                                        for (int j = 0; j < 4; ++j) { const float a = acc[ai][bj][m][n][j]; o[n][j] = (a * rs) * __builtin_amdgcn_rcpf(1.0f + __builtin_amdgcn_exp2f(a * nrs)); }
                                    *GP(u32x4, dst, lo2 + ai * AS2 + m * RS2 + 256 * bj) = pack8(o[0], o[1]); }
                                asm volatile("" ::: "memory");
                            }
                    }
                }
            } else if (u.kind == K_KV) {
                const bool isK = u.pn < 4; const int cb = 256 * (u.pn & 3);
                char* od = (char*)(F.out + (isK ? O_MK : O_MV) + ((size_t)l * NBATCH + u.pm) * NMEM * DM + cb);
                char* kb = (char*)((bf16_t*)(F.ws + WS_KB) + ((size_t)u.pm * NHEAD + (u.pn & 3)) * NMEM * HDIM);
                const unsigned lok = (rl * 256u + cl) * 2u;
#pragma unroll
                for (int ai = 0; ai < 2; ++ai)
#pragma unroll
                    for (int m = 0; m < 4; ++m) {
#pragma unroll
                        for (int bj = 0; bj < 2; ++bj) {
                            *GP(f32x4, od, lo4 + ai * AS4 + m * RS4 + 512 * bj) = acc[ai][bj][m][0]; *GP(f32x4, od, lo4 + ai * AS4 + m * RS4 + 512 * bj + 16) = acc[ai][bj][m][1];
                            if (isK) *GP(u32x4, kb, lok + (128 * ai + 16 * m) * 512u + 256 * bj) = pack8(acc[ai][bj][m][0], acc[ai][bj][m][1]);
                        }
                        asm volatile("" ::: "memory");
                    }
            } else {
                char* dst = (char*)((bf16_t*)(F.ws + WS_VT) + ((size_t)u.pn * DM + 256 * u.pm) * 256);
                const unsigned lo = (rl * 256u + cl) * 2u;
#pragma unroll
                for (int ai = 0; ai < 2; ++ai)
#pragma unroll
                    for (int m = 0; m < 4; ++m) {
#pragma unroll
                        for (int bj = 0; bj < 2; ++bj) *GP(u32x4, dst, lo + (128 * ai + 16 * m) * 512u + 256 * bj) = pack8(acc[ai][bj][m][0], acc[ai][bj][m][1]);
                        asm volatile("" ::: "memory");
                    }
            }
        }
        if constexpr (PH == 3) { if (u.kind == K_S) {
            LAS f32x2* X = (LAS f32x2*)(lds + XTRA_OFF);
            float mw[2][4];
#pragma unroll
            for (int ai = 0; ai < 2; ++ai)
#pragma unroll
                for (int m = 0; m < 4; ++m) {
                    float mx = -3.0e38f;
#pragma unroll
                    for (int bj = 0; bj < 2; ++bj)
#pragma unroll
                        for (int n = 0; n < 2; ++n) { acc[ai][bj][m][n] = acc[ai][bj][m][n] * LOG2E; const f32x4 x = acc[ai][bj][m][n]; mx = fmaxf(mx, fmaxf(fmaxf(x[0], x[1]), fmaxf(x[2], x[3]))); }
                    mx = fmaxf(mx, __shfl_xor(mx, 16)); mx = fmaxf(mx, __shfl_xor(mx, 32));
                    float sm = 0.f;
#pragma unroll
                    for (int bj = 0; bj < 2; ++bj)
#pragma unroll
                        for (int n = 0; n < 2; ++n) { f32x4 x = acc[ai][bj][m][n];
#pragma unroll
                            for (int j = 0; j < 4; ++j) x[j] = __builtin_amdgcn_exp2f(x[j] - mx);
                            acc[ai][bj][m][n] = x; sm += (x[0] + x[1]) + (x[2] + x[3]); }
                    sm += __shfl_xor(sm, 16); sm += __shfl_xor(sm, 32);
                    mw[ai][m] = mx;
                    if (fq == 0) X[(rl + 128 * ai + 16 * m) * 4 + wc] = (f32x2){mx, sm};
                    asm volatile("" ::: "memory");
                }
            LDS_WAIT(); __builtin_amdgcn_s_barrier(); asm volatile("" ::: "memory");
            char* dst = (char*)((bf16_t*)(F.ws + WS_PS) + (size_t)u.pm * 256 * DM + 256 * u.pn);
#pragma unroll
            for (int ai = 0; ai < 2; ++ai)
#pragma unroll
                for (int m = 0; m < 4; ++m) {
                    const unsigned r = rl + 128 * ai + 16 * m;
                    const f32x2 p0 = X[r * 4 + 0], p1 = X[r * 4 + 1], p2 = X[r * 4 + 2], p3 = X[r * 4 + 3];
                    const float M = fmaxf(fmaxf(p0.x, p1.x), fmaxf(p2.x, p3.x));
                    const float Ls = p0.y * __builtin_amdgcn_exp2f(p0.x - M) + p1.y * __builtin_amdgcn_exp2f(p1.x - M) + p2.y * __builtin_amdgcn_exp2f(p2.x - M) + p3.y * __builtin_amdgcn_exp2f(p3.x - M);
                    const float f = __builtin_amdgcn_exp2f(mw[ai][m] - M) * __builtin_amdgcn_rcpf(Ls);
#pragma unroll
                    for (int bj = 0; bj < 2; ++bj) *GP(u32x4, dst, lo2 + ai * AS2 + m * RS2 + 256 * bj) = pack8(acc[ai][bj][m][0] * f, acc[ai][bj][m][1] * f);
                    asm volatile("" ::: "memory");
                }
            asm volatile("s_waitcnt vmcnt(0) lgkmcnt(0)" ::: "memory"); __builtin_amdgcn_s_barrier(); asm volatile("" ::: "memory");
        } else {
            const size_t tb = (size_t)u.pm * 256 * DM + 256 * u.pn;
            if (u.kind == K_O) {
                const char* g = (const char*)(F.z(Z_SGA) + tb); char* dst = (char*)((bf16_t*)(F.ws + WS_AATT) + tb);
                u32x4 gw[2][4][2];
#pragma unroll
                for (int ai = 0; ai < 2; ++ai)
#pragma unroll
                    for (int m = 0; m < 4; ++m)
#pragma unroll
                        for (int bj = 0; bj < 2; ++bj) gw[ai][m][bj] = *GPC(u32x4, g, lo2 + ai * AS2 + m * RS2 + 256 * bj);
#pragma unroll
                for (int ai = 0; ai < 2; ++ai) {
#pragma unroll
                    for (int m = 0; m < 4; ++m)
#pragma unroll
                        for (int bj = 0; bj < 2; ++bj) { f32x4 g0, g1; unpack8(gw[ai][m][bj], g0, g1);
                            *GP(u32x4, dst, lo2 + ai * AS2 + m * RS2 + 256 * bj) = pack8(acc[ai][bj][m][0] * g0, acc[ai][bj][m][1] * g1); }
                    asm volatile("" ::: "memory");
                }
            } else {
                const char* g = (const char*)(F.z(Z_SGP) + tb); char* dst = (char*)((bf16_t*)(F.ws + WS_APOOL) + tb);
                const char* ps = (const char*)(F.in[I_PSCALE] + (size_t)l * DM + 256 * u.pn);
                f32x4 sc[2][2];
#pragma unroll
                for (int bj = 0; bj < 2; ++bj) { sc[bj][0] = *GPC(f32x4, ps, (cl + 128 * bj) * 4u); sc[bj][1] = *GPC(f32x4, ps, (cl + 128 * bj) * 4u + 16); }
                u32x4 gw[2][4][2];
#pragma unroll
                for (int ai = 0; ai < 2; ++ai)
#pragma unroll
                    for (int m = 0; m < 4; ++m)
#pragma unroll
                        for (int bj = 0; bj < 2; ++bj) gw[ai][m][bj] = *GPC(u32x4, g, lo2 + ai * AS2 + m * RS2 + 256 * bj);
#pragma unroll
                for (int ai = 0; ai < 2; ++ai) {
#pragma unroll
                    for (int m = 0; m < 4; ++m)
#pragma unroll
                        for (int bj = 0; bj < 2; ++bj) { f32x4 g0, g1; unpack8(gw[ai][m][bj], g0, g1);
                            *GP(u32x4, dst, lo2 + ai * AS2 + m * RS2 + 256 * bj) = pack8(acc[ai][bj][m][0] * sc[bj][0] * g0, acc[ai][bj][m][1] * sc[bj][1] * g1); }
                    asm volatile("" ::: "memory");
                }
            }
        } }
        if constexpr (PH == 4) {
            const size_t tb = (size_t)u.pm * 256 * DM + 256 * u.pn;
            const char* g = (const char*)(F.z(Z_SMC) + tb) + (size_t)u.aux * SLOT; char* dst = (char*)((bf16_t*)(F.ws + WS_MRG) + tb);
            u32x4 gw[2][4][2];
#pragma unroll
            for (int ai = 0; ai < 2; ++ai)
#pragma unroll
                for (int m = 0; m < 4; ++m)
#pragma unroll
                    for (int bj = 0; bj < 2; ++bj) gw[ai][m][bj] = *GPC(u32x4, g + (ai * AS2 + m * RS2), lo2 + 256 * bj);
            if (u.aux < 2) {
#pragma unroll
                for (int ai = 0; ai < 2; ++ai)
#pragma unroll
                    for (int m = 0; m < 4; ++m) {
#pragma unroll
                        for (int bj = 0; bj < 2; ++bj) { f32x4 g0, g1; u32x4 w = gw[ai][m][bj]; asm volatile("" : "+v"(w));
                            unpack8(w, g0, g1); acc[ai][bj][m][0] *= g0; acc[ai][bj][m][1] *= g1; }
                    }
            } else {
#pragma unroll
                for (int ai = 0; ai < 2; ++ai) {
#pragma unroll
                    for (int m = 0; m < 4; ++m)
#pragma unroll
                        for (int bj = 0; bj < 2; ++bj) { f32x4 g0, g1; unpack8(gw[ai][m][bj], g0, g1);
                            *GP(u32x4, dst, lo2 + ai * AS2 + m * RS2 + 256 * bj) = pack8(acc[ai][bj][m][0] * g0, acc[ai][bj][m][1] * g1); }
                    asm volatile("" ::: "memory");
                }
            }
        }
        if constexpr (PH == 5) {
            const size_t tb = (size_t)u.pm * 256 * DM + 256 * u.pn;
            constexpr bool first = false; const bool last = (l + 1 == DEPTH);
            const char* xo = first ? (const char*)(((u.pm < 64) ? F.in[I_XP] : F.in[I_XS] - (size_t)MP * DM) + tb) : (const char*)((const bf16_t*)(F.ws + WS_XG) + tb);
            char* xn = (char*)(F.out + tb);
            char* xg = (char*)((bf16_t*)(F.ws + WS_XG) + tb);
            float* rss = F.rss(l + 1) + u.pm * 256;
#define OUT_ROWS(ai, m, X0, X1) do { float ss = 0.f; \
                _Pragma("unroll") for (int bj = 0; bj < 2; ++bj) { const unsigned o = lo4 + (ai) * AS4 + (m) * RS4 + 512 * bj; \
                    const f32x4 v0 = X0[bj] + acc[ai][bj][m][0], v1 = X1[bj] + acc[ai][bj][m][1]; \
                    ss += (v0[0] * v0[0] + v0[1] * v0[1]) + (v0[2] * v0[2] + v0[3] * v0[3]) + (v1[0] * v1[0] + v1[1] * v1[1]) + (v1[2] * v1[2] + v1[3] * v1[3]); \
                    if (last) { *GP(f32x4, xn, o) = v0; *GP(f32x4, xn, o + 16) = v1; } \
                    else *GP(u32x4, xg, lo2 + (ai) * AS2 + (m) * RS2 + 256 * bj) = pack8(v0, v1); } \
                ss += __shfl_xor(ss, 16); ss += __shfl_xor(ss, 32); \
                if (fq == 0 && rep == 0) __hip_atomic_fetch_add(GP(float, rss, (rl + 128 * (ai) + 16 * (m)) * 4u), ss, __ATOMIC_RELAXED, __HIP_MEMORY_SCOPE_AGENT); } while (0)
            if (first) {
#pragma unroll
                for (int ai = 0; ai < 2; ++ai)
#pragma unroll
                  for (int mh = 0; mh < 2; ++mh) {
                    f32x4 xv[2][2][2];
#pragma unroll
                    for (int mm = 0; mm < 2; ++mm)
#pragma unroll
                        for (int bj = 0; bj < 2; ++bj) { const unsigned o = lo4 + ai * AS4 + (2 * mh + mm) * RS4 + 512 * bj; xv[mm][0][bj] = *GPC(f32x4, xo, o); xv[mm][1][bj] = *GPC(f32x4, xo, o + 16); }
#pragma unroll
                    for (int mm = 0; mm < 2; ++mm) OUT_ROWS(ai, 2 * mh + mm, xv[mm][0], xv[mm][1]);
                    asm volatile("" ::: "memory");
                  }
            } else {
#pragma unroll
                for (int ai = 0; ai < 2; ++ai) {
                    u32x4 xw[4][2];
#pragma unroll
                    for (int m = 0; m < 4; ++m)
#pragma unroll
                        for (int bj = 0; bj < 2; ++bj) xw[m][bj] = *GPC(u32x4, xo, lo2 + ai * AS2 + m * RS2 + 256 * bj);
#pragma unroll
                    for (int m = 0; m < 4; ++m) { f32x4 x0[2], x1[2];
#pragma unroll
                        for (int bj = 0; bj < 2; ++bj) unpack8(xw[m][bj], x0[bj], x1[bj]);
                        OUT_ROWS(ai, m, x0, x1); }
                    asm volatile("" ::: "memory");
                }
            }
#undef OUT_ROWS
        }
    }
};

__device__ __forceinline__ void satt_item(const Ctx& F0, int l, int b, int h) {
    Ctx F = F0; asm volatile("" : "+v"(F.tid)); F.lane = F.tid & 63;
    LAS float* S = (LAS float*)(F.lds + XTRA_OFF);
    LAS float* O = (LAS float*)(F.lds);
    const int lane = F.lane, w = F.wave;
    const size_t cbase = (((size_t)l * DBATCH + b) * NMEM + 32 * w) * DM + 256 * h + 4 * lane;
    const float* Kb = F.in[I_CK] + cbase; const float* Vb = F.in[I_CV] + cbase;
    f32x4 kv[32];
#pragma unroll
    for (int mi = 0; mi < 32; ++mi) kv[mi] = __builtin_nontemporal_load((const f32x4*)(Kb + (size_t)mi * DM));
    f32x4 q[4];
#pragma unroll
    for (int t = 0; t < 4; ++t) { const u32x2 v = *(const u32x2*)(F.z(Z_Q) + (size_t)(MP + 4 * b + t) * DM + 256 * h + 4 * lane); q[t] = (f32x4){bf_lo(v.x), bf_hi(v.x), bf_lo(v.y), bf_hi(v.y)}; }
    const bool hi5 = (lane & 32) != 0, hi4 = (lane & 16) != 0;
#pragma unroll
    for (int mi = 0; mi < 32; ++mi) {
        float d[4];
#pragma unroll
        for (int t = 0; t < 4; ++t) d[t] = (q[t][0] * kv[mi][0] + q[t][1] * kv[mi][1]) + (q[t][2] * kv[mi][2] + q[t][3] * kv[mi][3]);
        const float s0 = hi5 ? d[0] : d[2], k0 = hi5 ? d[2] : d[0], s1 = hi5 ? d[1] : d[3], k1 = hi5 ? d[3] : d[1];
        const float e0 = k0 + __shfl_xor(s0, 32), e1 = k1 + __shfl_xor(s1, 32);
        const float sx = hi4 ? e0 : e1, kx = hi4 ? e1 : e0;
        float f = kx + __shfl_xor(sx, 16);
        f += __builtin_bit_cast(float, __builtin_amdgcn_update_dpp(0, __builtin_bit_cast(int, f), 0xB1, 0xf, 0xf, false));
        f += __builtin_bit_cast(float, __builtin_amdgcn_update_dpp(0, __builtin_bit_cast(int, f), 0x4E, 0xf, 0xf, false));
        f += __builtin_bit_cast(float, __builtin_amdgcn_update_dpp(0, __builtin_bit_cast(int, f), 0x141, 0xf, 0xf, false));
        f += __builtin_bit_cast(float, __builtin_amdgcn_update_dpp(0, __builtin_bit_cast(int, f), 0x140, 0xf, 0xf, false));
        if ((lane & 15) == 0) S[(32 * w + mi) * 4 + (lane >> 4)] = f;
    }
    f32x4 vv[32];
#pragma unroll
    for (int mi = 0; mi < 32; ++mi) vv[mi] = __builtin_nontemporal_load((const f32x4*)(Vb + (size_t)mi * DM));
    __syncthreads();
    if (w < 4) {
        float s[4]; float mx = -3.0e38f;
#pragma unroll
        for (int i = 0; i < 4; ++i) { s[i] = S[(lane + 64 * i) * 4 + w] * LOG2E; mx = fmaxf(mx, s[i]); }
        mx = wave_max(mx); float sm = 0.f;
#pragma unroll
        for (int i = 0; i < 4; ++i) { s[i] = __builtin_amdgcn_exp2f(s[i] - mx); sm += s[i]; }
        sm = wave_sum(sm); const float inv = 1.0f / sm;
#pragma unroll
        for (int i = 0; i < 4; ++i) S[(lane + 64 * i) * 4 + w] = s[i] * inv;
    }
    __syncthreads();
    f32x4 o[4];
#pragma unroll
    for (int t = 0; t < 4; ++t) o[t] = (f32x4){0.f, 0.f, 0.f, 0.f};
#pragma unroll
    for (int mi = 0; mi < 32; ++mi) {
        const f32x4 p = *(const LAS f32x4*)(S + (32 * w + mi) * 4);
#pragma unroll
        for (int t = 0; t < 4; ++t) o[t] += vv[mi] * p[t];
    }
#pragma unroll
    for (int t = 0; t < 4; ++t) *(LAS f32x4*)(O + (w * 4 + t) * 256 + 4 * lane) = o[t];
    __syncthreads();
    if (F.tid < 128) {
        const int t = F.tid >> 5, c8 = (F.tid & 31) * 8;
        f32x4 a0 = (f32x4){0.f, 0.f, 0.f, 0.f}, a1 = a0;
#pragma unroll
        for (int ww = 0; ww < 8; ++ww) { a0 += *(const LAS f32x4*)(O + (ww * 4 + t) * 256 + c8); a1 += *(const LAS f32x4*)(O + (ww * 4 + t) * 256 + c8 + 4); }
        const size_t off = (size_t)(MP + 4 * b + t) * DM + 256 * h + c8;
        f32x4 g0, g1; unpack8(*(const u32x4*)(F.z(Z_SGA) + off), g0, g1);
        *(u32x4*)((bf16_t*)(F.ws + WS_AATT) + off) = pack8(a0 * g0, a1 * g1);
    }
    __syncthreads();
}

#define SATT_BASE(item) ((((size_t)l * DBATCH + ((item) >> 2)) * NMEM + 32 * w) * DM + 256 * ((item) & 3))
#define SATT_LOAD(buf, ptr) do { _Pragma("unroll") for (int mi = 0; mi < 16; ++mi) buf[mi] = __builtin_nontemporal_load((const f32x4*)((const char*)((ptr) + (size_t)mi * DM) + loff)); } while (0)
template <bool HAS_NEXT> __device__ __forceinline__ void satt_body(const Ctx& F, int l, int it, int nx, f32x4 (&A)[16], f32x4 (&B)[16], unsigned loff) {
    LAS float* S = (LAS float*)(F.lds + XTRA_OFF);
    LAS float* O = (LAS float*)(F.lds);
    const int lane = F.lane, w = F.wave;
    const bool hi5 = (lane & 32) != 0, hi4 = (lane & 16) != 0;
    const int b = it >> 2, h = it & 3;
    const size_t cb = SATT_BASE(it), cn = SATT_BASE(nx);
    f32x4 q[4];
#pragma unroll
    for (int t = 0; t < 4; ++t) { const u32x2 v = *(const u32x2*)(F.z(Z_Q) + (size_t)(MP + 4 * b + t) * DM + 256 * h + 4 * lane); q[t] = (f32x4){bf_lo(v.x), bf_hi(v.x), bf_lo(v.y), bf_hi(v.y)}; }
#define SATT_QK(buf, m0) do { _Pragma("unroll") for (int mi = 0; mi < 16; ++mi) { float d[4]; \
        _Pragma("unroll") for (int t = 0; t < 4; ++t) d[t] = (q[t][0] * buf[mi][0] + q[t][1] * buf[mi][1]) + (q[t][2] * buf[mi][2] + q[t][3] * buf[mi][3]); \
        const float s0 = hi5 ? d[0] : d[2], k0 = hi5 ? d[2] : d[0], s1 = hi5 ? d[1] : d[3], k1 = hi5 ? d[3] : d[1]; \
        const float e0 = k0 + __shfl_xor(s0, 32), e1 = k1 + __shfl_xor(s1, 32); \
        const float sx = hi4 ? e0 : e1, kx = hi4 ? e1 : e0; \
        float f = kx + __shfl_xor(sx, 16); \
        f += __builtin_bit_cast(float, __builtin_amdgcn_update_dpp(0, __builtin_bit_cast(int, f), 0xB1, 0xf, 0xf, false)); \
        f += __builtin_bit_cast(float, __builtin_amdgcn_update_dpp(0, __builtin_bit_cast(int, f), 0x4E, 0xf, 0xf, false)); \
        f += __builtin_bit_cast(float, __builtin_amdgcn_update_dpp(0, __builtin_bit_cast(int, f), 0x141, 0xf, 0xf, false)); \
        f += __builtin_bit_cast(float, __builtin_amdgcn_update_dpp(0, __builtin_bit_cast(int, f), 0x140, 0xf, 0xf, false)); \
        if ((lane & 15) == 0) S[(32 * w + (m0) + mi) * 4 + (lane >> 4)] = f; } } while (0)
#define SATT_PV(buf, m0) do { _Pragma("unroll") for (int mi = 0; mi < 16; ++mi) { const f32x4 p = *(const LAS f32x4*)(S + (32 * w + (m0) + mi) * 4); \
        _Pragma("unroll") for (int t = 0; t < 4; ++t) o[t] += buf[mi] * p[t]; } } while (0)
    __builtin_amdgcn_sched_barrier(0);
    SATT_QK(A, 0);
    __builtin_amdgcn_sched_barrier(0);
    SATT_LOAD(A, F.in[I_CV] + cb);
    __builtin_amdgcn_sched_barrier(0);
    SATT_QK(B, 16);
    __builtin_amdgcn_sched_barrier(0);
    SATT_LOAD(B, F.in[I_CV] + cb + (size_t)16 * DM);
    __builtin_amdgcn_sched_barrier(0);
    __syncthreads();
    if (w < 4) {
        float s[4]; float mx = -3.0e38f;
#pragma unroll
        for (int i = 0; i < 4; ++i) { s[i] = S[(lane + 64 * i) * 4 + w] * LOG2E; mx = fmaxf(mx, s[i]); }
        mx = wave_max(mx); float sm = 0.f;
#pragma unroll
        for (int i = 0; i < 4; ++i) { s[i] = __builtin_amdgcn_exp2f(s[i] - mx); sm += s[i]; }
        sm = wave_sum(sm); const float inv = 1.0f / sm;
#pragma unroll
        for (int i = 0; i < 4; ++i) S[(lane + 64 * i) * 4 + w] = s[i] * inv;
    }
    __syncthreads();
    f32x4 o[4];
#pragma unroll
    for (int t = 0; t < 4; ++t) o[t] = (f32x4){0.f, 0.f, 0.f, 0.f};
    SATT_PV(A, 0);
    __builtin_amdgcn_sched_barrier(0);
    if constexpr (HAS_NEXT) SATT_LOAD(A, F.in[I_CK] + cn);
    __builtin_amdgcn_sched_barrier(0);
    SATT_PV(B, 16);
    __builtin_amdgcn_sched_barrier(0);
    if constexpr (HAS_NEXT) SATT_LOAD(B, F.in[I_CK] + cn + (size_t)16 * DM);
    __builtin_amdgcn_sched_barrier(0);
#pragma unroll
    for (int t = 0; t < 4; ++t) *(LAS f32x4*)(O + (w * 4 + t) * 256 + 4 * lane) = o[t];
    __syncthreads();
    if (F.tid < 128) {
        const int t = F.tid >> 5, c8 = (F.tid & 31) * 8;
        f32x4 a0 = (f32x4){0.f, 0.f, 0.f, 0.f}, a1 = a0;
#pragma unroll
        for (int ww = 0; ww < 8; ++ww) { a0 += *(const LAS f32x4*)(O + (ww * 4 + t) * 256 + c8); a1 += *(const LAS f32x4*)(O + (ww * 4 + t) * 256 + c8 + 4); }
        const size_t off = (size_t)(MP + 4 * b + t) * DM + 256 * h + c8;
        f32x4 g0, g1; unpack8(*(const u32x4*)(F.z(Z_SGA) + off), g0, g1);
        *(u32x4*)((bf16_t*)(F.ws + WS_AATT) + off) = pack8(a0 * g0, a1 * g1);
    }
    __syncthreads();
#undef SATT_QK
#undef SATT_PV
}
__device__ __forceinline__ void satt_pair(const Ctx& F0, int l, int it0, int it1) {
    Ctx F = F0; asm volatile("" : "+v"(F.tid)); F.lane = F.tid & 63;
    const int w = F.wave;
    unsigned loff = (unsigned)F.lane * 16u; asm volatile("" : "+v"(loff));
    f32x4 A[16], B[16];
    { const size_t cb = SATT_BASE(it0); SATT_LOAD(A, F.in[I_CK] + cb); SATT_LOAD(B, F.in[I_CK] + cb + (size_t)16 * DM); }
    satt_body<true>(F, l, it0, it1, A, B, loff);
    satt_body<false>(F, l, it1, it1, A, B, loff);
}
#undef SATT_BASE
#undef SATT_LOAD
__device__ __forceinline__ void satt_stream(const Ctx& F, int l) {
    int it = F.c;
#pragma nounroll
    for (; it + F.G < 512; it += 2 * F.G) satt_pair(F, l, it, it + F.G);
    if (it < 512) satt_item(F, l, it >> 2, it & 3);
}

struct V8 { f32x4 a, b; };
__device__ __forceinline__ V8 v8_zero() { V8 r; r.a = (f32x4){0.f, 0.f, 0.f, 0.f}; r.b = r.a; return r; }
__device__ __forceinline__ V8 ld_bf8(const bf16_t* p) { V8 r; unpack8(*(const u32x4*)p, r.a, r.b); return r; }
__device__ __forceinline__ V8 ld_f8(const float* p) { V8 r; r.a = *(const f32x4*)p; r.b = *(const f32x4*)(p + 4); return r; }
template <int W, bool PROMPT> __device__ __forceinline__ void cm_task(const Ctx& F, int l, int rq, int c0) {
    const bf16_t* U = F.z(Z_U) + c0; const bf16_t* BS = F.z(Z_BS) + c0; const bf16_t* HP = F.z(Z_HP) + c0;
    bf16_t* AC = (bf16_t*)(F.ws + WS_ACONV) + c0; bf16_t* MX = (bf16_t*)(F.ws + WS_MIX) + c0;
    const int r0 = 4 * rq, t0 = r0 & (SEQ - 1), b = rq - MP / 4;
    const f32x4 z4 = (f32x4){0.f, 0.f, 0.f, 0.f};
    u32x4 uw[6], bw[4], xw[W + 3];
    V8 us[2];
    const float* sp = F.in[I_SPOOL] + ((size_t)l * DBATCH + b) * 15 * DM + c0;
    if constexpr (PROMPT) {
#pragma unroll
        for (int j = 0; j < 6; ++j) { const int row = (j >= 2 || t0 != 0) ? r0 - 2 + j : r0; uw[j] = *(const u32x4*)(U + (size_t)row * DM); }
#pragma unroll
        for (int j = 0; j < W + 3; ++j) { const int row = (t0 - (W - 1) + j >= 0) ? r0 - (W - 1) + j : r0; xw[j] = *(const u32x4*)(HP + (size_t)row * DM); }
    } else {
        const float* sc = F.in[I_SCONV] + ((size_t)l * DBATCH + b) * 2 * DM + c0;
#pragma unroll
        for (int j = 0; j < 2; ++j) us[j] = ld_f8(sc + j * DM);
#pragma unroll
        for (int j = 2; j < 6; ++j) uw[j] = *(const u32x4*)(U + (size_t)(r0 - 2 + j) * DM);
#pragma unroll
        for (int j = 0; j < W + 3; ++j) { constexpr int dummy = 0; (void)dummy; const int e = 16 - W + j;
            if (e >= 15) xw[j] = *(const u32x4*)(HP + (size_t)(r0 + e - 15) * DM); }
    }
    V8 tpre[8];
    if constexpr (!PROMPT) {
#pragma unroll
        for (int i = 0; i < 8; ++i) if (i < W - 1) tpre[i] = ld_f8(sp + (size_t)(16 - W + i) * DM);
    }
#pragma unroll
    for (int k = 0; k < 4; ++k) bw[k] = *(const u32x4*)(BS + (size_t)(r0 + k) * DM);
    const float* cw = F.in[I_CONVW] + (size_t)l * 3 * DM + c0;
    const V8 w0 = ld_f8(cw), w1 = ld_f8(cw + DM), w2 = ld_f8(cw + 2 * DM);
    {
        V8 u[6];
#pragma unroll
        for (int j = 0; j < 6; ++j) {
            if (PROMPT || j >= 2) { unpack8(uw[j], u[j].a, u[j].b); if (PROMPT && j < 2 && t0 == 0) { u[j].a = z4; u[j].b = z4; } }
            else u[j] = us[j];
        }
#pragma unroll
        for (int k = 0; k < 4; ++k) {
            V8 bs; unpack8(bw[k], bs.a, bs.b);
            const f32x4 y0 = w0.a * u[k].a + w1.a * u[k + 1].a + w2.a * u[k + 2].a, y1 = w0.b * u[k].b + w1.b * u[k + 1].b + w2.b * u[k + 2].b;
            *(u32x4*)(AC + (size_t)(r0 + k) * DM) = pack8(bs.a * y0, bs.b * y1);
        }
    }
    {
        auto gettok = [&](int j) -> V8 { V8 v; unpack8(xw[j], v.a, v.b); return v; };
        V8 s = v8_zero(), x0 = s, x1 = s, x2 = s;
        if constexpr (PROMPT) {
#pragma unroll
            for (int j = 0; j < W; ++j) { V8 v = gettok(j); if (j < W - 1 && t0 - (W - 1) + j < 0) { v.a = z4; v.b = z4; }
                s.a += v.a; s.b += v.b; if (j == 0) x0 = v; if (j == 1) x1 = v; if (j == 2) x2 = v; }
            if (W == 2) x2 = gettok(2);
        } else {
            constexpr int NS = W - 1;
#pragma unroll
            for (int j0 = 0; j0 < NS; j0 += 8) {
                V8 t[8];
#pragma unroll
                for (int i = 0; i < 8; ++i) if (j0 + i < NS) { if (j0 == 0) t[i] = tpre[i]; else t[i] = ld_f8(sp + (size_t)(16 - W + j0 + i) * DM); }
#pragma unroll
                for (int i = 0; i < 8; ++i) if (j0 + i < NS) { const int j = j0 + i; s.a += t[i].a; s.b += t[i].b; if (j == 0) x0 = t[i]; if (j == 1) x1 = t[i]; if (j == 2) x2 = t[i]; }
            }
            { const V8 v = gettok(W - 1); s.a += v.a; s.b += v.b; if (W - 1 == 1) x1 = v; if (W - 1 == 2) x2 = v; }
            if (W == 2) x2 = gettok(2);
        }
#pragma unroll
        for (int k = 0; k < 4; ++k) {
            const V8 tk = gettok(W - 1 + k);
            const int cnt = PROMPT ? ((t0 + k + 1 < W) ? (t0 + k + 1) : W) : W;
            const float inv = 1.0f / (float)cnt;
            *(u32x4*)(MX + (size_t)(r0 + k) * DM) = pack8(s.a * inv - tk.a, s.b * inv - tk.b);
            if (k < 3) { const V8 xo = (k == 0) ? x0 : (k == 1 ? x1 : x2), xn = gettok(W + k); s.a += xn.a - xo.a; s.b += xn.b - xo.b; }
        }
    }
}

template <int K> __device__ __forceinline__ f32x4 small_tile(const Ctx& F, const bf16_t* A, int lda, const bf16_t* Bt, int ldb, int lane) {
    constexpr int KS = K / 8 / 32;
    const int fr = lane & 15, fq = lane >> 4, w = F.wave;
    const bf16_t* ap = A + (size_t)fr * lda + w * (K / 8) + 8 * fq;
    const bf16_t* bp = Bt + (size_t)fr * ldb + w * (K / 8) + 8 * fq;
    bf16x8 a[4][KS], b[2][KS];
#pragma unroll
    for (int ks = 0; ks < KS; ++ks) {
#pragma unroll
        for (int cg = 0; cg < 2; ++cg) b[cg][ks] = *(const bf16x8*)(bp + (size_t)(16 * cg) * ldb + 32 * ks);
#pragma unroll
        for (int rg = 0; rg < 4; ++rg) a[rg][ks] = *(const bf16x8*)(ap + (size_t)(16 * rg) * lda + 32 * ks);
    }
    __builtin_amdgcn_sched_barrier(0);
    LAS f32x4* P = (LAS f32x4*)F.lds;
#pragma unroll
    for (int rg = 0; rg < 4; ++rg)
#pragma unroll
        for (int cg = 0; cg < 2; ++cg) {
            f32x4 acc = (f32x4){0.f, 0.f, 0.f, 0.f};
#pragma unroll
            for (int ks = 0; ks < KS; ++ks) acc = __builtin_amdgcn_mfma_f32_16x16x32_bf16(b[cg][ks], a[rg][ks], acc, 0, 0, 0);
            P[(w * 8 + rg * 2 + cg) * 64 + lane] = acc;
        }
    __syncthreads();
    f32x4 s = P[(0 * 8 + w) * 64 + lane];
#pragma unroll
    for (int ww = 1; ww < 8; ++ww) s += P[(ww * 8 + w) * 64 + lane];
    __syncthreads();
    return s;
}
__device__ __forceinline__ f32x4 ld_bf4(const bf16_t* p) { const u32x2 v = *(const u32x2*)p; return (f32x4){bf_lo(v.x), bf_hi(v.x), bf_lo(v.y), bf_hi(v.y)}; }
__device__ __forceinline__ void st_bf4(bf16_t* p, f32x4 v) { u32x2 w; w.x = cvt_pk_bf16(v[0], v[1]); w.y = cvt_pk_bf16(v[2], v[3]); *(u32x2*)p = w; }
#define SMALL_IDS() int lane = F.lane; asm volatile("" : "+v"(lane)); const int fr = lane & 15, fq = lane >> 4; \
    const int r0 = MP + 64 * (t >> 5), n0 = 32 * (t & 31), row = r0 + 16 * (F.wave >> 1) + fr, col = n0 + 16 * (F.wave & 1) + 4 * fq; \
    const size_t off = (size_t)row * DM + col
__device__ __forceinline__ void small_pool(const Ctx& F, int l) {
    for (int t = F.c; t < 256; t += F.G) { SMALL_IDS();
        const int g = n0 >> 8;
        const f32x4 ps = *(const f32x4*)(F.in[I_PSCALE] + (size_t)l * DM + col), sg = ld_bf4(F.z(Z_SGP) + off);
        const f32x4 acc = small_tile<256>(F, (const bf16_t*)(F.ws + WS_MIX) + (size_t)r0 * DM + 256 * g, DM, (const bf16_t*)(F.ws + WS_PW) + (((size_t)l * 4 + g) * 256 + (n0 & 255)) * 256, 256, lane);
        st_bf4((bf16_t*)(F.ws + WS_APOOL) + off, acc * ps * sg);
    }
}
constexpr int SS_PITCH = 144, SS_SLAB = 96 * SS_PITCH;
constexpr int SS_GATE_OFF = 8 * SS_SLAB;
static_assert(SS_GATE_OFF + 3 * 64 * 64 <= XTRA_OFF, "small-tile LDS map");
struct SmallStage { u32x4 a[8], b[4]; };
__device__ __forceinline__ void small_stage_load(SmallStage& s, const bf16_t* ap, const bf16_t* bp) {
#pragma unroll
    for (int q = 0; q < 8; ++q) s.a[q] = *(const u32x4*)(ap + (size_t)(8 * q) * DM);
#pragma unroll
    for (int q = 0; q < 4; ++q) s.b[q] = *(const u32x4*)(bp + (size_t)(8 * q) * DM);
}
__device__ __forceinline__ void small_stage_mma(const SmallStage& s, LAS unsigned char* wl, unsigned wo, unsigned ro, f32x4 (&tot)[4][2]) {
#pragma unroll
    for (int q = 0; q < 8; ++q) *(LAS u32x4*)(wl + wo + q * (8 * SS_PITCH)) = s.a[q];
#pragma unroll
    for (int q = 0; q < 4; ++q) *(LAS u32x4*)(wl + wo + (64 + 8 * q) * SS_PITCH) = s.b[q];
    bf16x8 a[4][2], b[2][2];
#pragma unroll
    for (int ks = 0; ks < 2; ++ks) {
#pragma unroll
        for (int cg = 0; cg < 2; ++cg) b[cg][ks] = *(const LAS bf16x8*)(wl + ro + (64 + 16 * cg) * SS_PITCH + 64 * ks);
#pragma unroll
        for (int rg = 0; rg < 4; ++rg) a[rg][ks] = *(const LAS bf16x8*)(wl + ro + (16 * rg) * SS_PITCH + 64 * ks);
    }
#pragma unroll
    for (int rg = 0; rg < 4; ++rg)
#pragma unroll
        for (int cg = 0; cg < 2; ++cg)
#pragma unroll
            for (int ks = 0; ks < 2; ++ks) tot[rg][cg] = __builtin_amdgcn_mfma_f32_16x16x32_bf16(b[cg][ks], a[rg][ks], tot[rg][cg], 0, 0, 0);
}
__device__ __forceinline__ f32x4 small_reduce(const Ctx& F, const f32x4 (&tot)[4][2], int lane) {
    LAS f32x4* P = (LAS f32x4*)F.lds;
    const int w = F.wave;
    __syncthreads();
#pragma unroll
    for (int rg = 0; rg < 4; ++rg)
#pragma unroll
        for (int cg = 0; cg < 2; ++cg) P[(w * 8 + rg * 2 + cg) * 64 + lane] = tot[rg][cg];
    __syncthreads();
    f32x4 s = P[(0 * 8 + w) * 64 + lane];
#pragma unroll
    for (int ww = 1; ww < 8; ++ww) s += P[(ww * 8 + w) * 64 + lane];
    __syncthreads();
    return s;
}
#define SMALL_STAGE_IDS() const int w = F.wave; LAS unsigned char* wl = F.lds + w * SS_SLAB; \
    const unsigned wo = (unsigned)((lane >> 3) * SS_PITCH + (lane & 7) * 16), ro = (unsigned)(fr * SS_PITCH + fq * 16); \
    const size_t lrow = (size_t)(lane >> 3) * DM + w * 128 + 8 * (lane & 7)
__device__ __forceinline__ void small_branches(const Ctx& F, int l) {
    for (int t = F.c; t < 256; t += F.G) { SMALL_IDS(); SMALL_STAGE_IDS();
        const bf16_t* ap = (const bf16_t*)(F.ws + WS_ACONV) + (size_t)r0 * DM + lrow;
        const bf16_t* bp = (const bf16_t*)(F.ws + WS_WBR) + (((size_t)l * 3) * DM + n0) * DM + lrow;
#define SB_A(s) ((const bf16_t*)((const char*)ap + (size_t)((s) >> 1) * SLOT) + 64 * ((s) & 1))
#define SB_B(s) (bp + (size_t)((s) >> 1) * DM * DM + 64 * ((s) & 1))
        u32x4 gv[2];
        int tid_ = F.tid; asm volatile("" : "+v"(tid_));
#pragma unroll
        for (int i = 0; i < 2; ++i) { const int p = tid_ + 512 * i; if (p < 768) gv[i] = *(const u32x4*)((const char*)(F.z(Z_SMC) + (size_t)(r0 + ((p & 255) >> 2)) * DM + n0 + 8 * (p & 3)) + (size_t)(p >> 8) * SLOT); }
        SmallStage st[3];
        f32x4 tot[4][2];
#pragma unroll
        for (int rg = 0; rg < 4; ++rg)
#pragma unroll
            for (int cg = 0; cg < 2; ++cg) tot[rg][cg] = (f32x4){0.f, 0.f, 0.f, 0.f};
        small_stage_load(st[0], SB_A(0), SB_B(0)); small_stage_load(st[1], SB_A(1), SB_B(1));
        __builtin_amdgcn_sched_barrier(0);
#pragma unroll
        for (int i = 0; i < 2; ++i) { const int p = tid_ + 512 * i; if (p < 768) *(LAS u32x4*)(F.lds + SS_GATE_OFF + 16 * p) = gv[i]; }
#pragma unroll
        for (int s = 0; s < 6; ++s) {
            if (s + 2 < 6) small_stage_load(st[(s + 2) % 3], SB_A(s + 2), SB_B(s + 2));
            __builtin_amdgcn_sched_barrier(0);
            small_stage_mma(st[s % 3], wl, wo, ro, tot);
            if (s & 1) {
                if (s == 1) __syncthreads();
                const LAS unsigned char* gl = F.lds + SS_GATE_OFF + (s >> 1) * 4096 + fr * 64 + fq * 8;
#pragma unroll
                for (int rg = 0; rg < 4; ++rg)
#pragma unroll
                    for (int cg = 0; cg < 2; ++cg) { const u32x2 g = *(const LAS u32x2*)(gl + rg * 1024 + cg * 32); tot[rg][cg] = tot[rg][cg] * (f32x4){bf_lo(g.x), bf_hi(g.x), bf_lo(g.y), bf_hi(g.y)}; }
            }
            __builtin_amdgcn_sched_barrier(0);
        }
#undef SB_A
#undef SB_B
        const f32x4 s4 = small_reduce(F, tot, lane);
        st_bf4((bf16_t*)(F.ws + WS_MRG) + off, s4);
    }
}
__device__ __forceinline__ void small_out(const Ctx& F, int l) {
    for (int t = F.c; t < 256; t += F.G) { SMALL_IDS(); SMALL_STAGE_IDS();
        f32x4 xold;
        xold = ld_bf4((const bf16_t*)(F.ws + WS_XG) + off);
        const bf16_t* ap = (const bf16_t*)(F.ws + WS_MRG) + (size_t)r0 * DM + lrow;
        const bf16_t* bp = (const bf16_t*)(F.ws + WS_WO) + ((size_t)l * DM + n0) * DM + lrow;
        SmallStage st[2];
        f32x4 tot[4][2];
#pragma unroll
        for (int rg = 0; rg < 4; ++rg)
#pragma unroll
            for (int cg = 0; cg < 2; ++cg) tot[rg][cg] = (f32x4){0.f, 0.f, 0.f, 0.f};
        small_stage_load(st[0], ap, bp); small_stage_load(st[1], ap + 64, bp + 64);
        __builtin_amdgcn_sched_barrier(0);
        small_stage_mma(st[0], wl, wo, ro, tot);
        __builtin_amdgcn_sched_barrier(0);
        small_stage_mma(st[1], wl, wo, ro, tot);
        const f32x4 acc = small_reduce(F, tot, lane);
        const f32x4 v = xold + acc;
        if (l + 1 < DEPTH) st_bf4((bf16_t*)(F.ws + WS_XG) + off, v); else *(f32x4*)(F.out + off) = v;
        float ss = (v[0] * v[0] + v[1] * v[1]) + (v[2] * v[2] + v[3] * v[3]);
        ss += __shfl_xor(ss, 16); ss += __shfl_xor(ss, 32);
        if (fq == 0) __hip_atomic_fetch_add(F.rss(l + 1) + row, ss, __ATOMIC_RELAXED, __HIP_MEMORY_SCOPE_AGENT);
    }
}

__global__ void __launch_bounds__(NWAVES * 64, 2) fwd_megakernel(Args args) {
    extern __shared__ __attribute__((aligned(16))) unsigned char lds_raw[];
    Ctx F;
#pragma unroll
    for (int i = 0; i < 19; ++i) F.in[i] = args.in[i];
    F.out = args.out; F.ws = args.ws;
    F.lds = (LAS unsigned char*)lds_raw;
    F.tid = threadIdx.x; F.lane = F.tid & 63; F.wave = __builtin_amdgcn_readfirstlane(F.tid >> 6);
    F.G = gridDim.x; F.c = blockIdx.x; F.vcu = (F.G % 8 == 0) ? (F.c % 8) * (F.G / 8) + F.c / 8 : F.c;
    volatile LAS unsigned* MISC = (volatile LAS unsigned*)(F.lds + MISC_OFF);
    if (F.tid < 32) MISC[F.tid] = 0u;
    __syncthreads();
    unsigned* ctl = (unsigned*)(F.ws + WS_CTL);
    XcdBarrier bar = xcd_barrier_post(ctl + CW_BAR, MISC + 8);
#define GRID_BAR() xcd_barrier(bar)

    for (int rep = 0; rep < (REP_PH == 6 ? 2 : 1); ++rep) {
    p0_prologue(F);
    GRID_BAR();
    }
    const char* ws = (const char*)F.ws;
#pragma nounroll
    for (int l = 0; l < DEPTH; ++l) {
        for (int rep = 0; rep < (REP_PH == 1 ? 2 : 1); ++rep) {
            SchedP1 S{F.G, F.c, ws + WS_XG, ws + WS_WIN + (size_t)l * DIN * DM * 2, ws + WS_HM + (size_t)l * NBATCH * NMEM * DM * 2, ws + WS_WKV + (size_t)l * 2048 * DM * 2};
            Epi<1> E{F, l};
            pg8::gemm_phase(F.lds, DM, DM, DM, S, E);
            if (l + 1 < DEPTH && rep == 0) {
                const int nfull = 3000 % F.G, j = F.c - nfull;
                if (j >= 0) convert_weights(F, (l + 1) * XI_PER_LAYER, (l + 1) * XI_PER_LAYER + XI_LATE, j * NWAVES + F.wave, (F.G - nfull) * NWAVES);
            }
        GRID_BAR();
        }
        for (int rep = 0; rep < (REP_PH == 2 ? 2 : 1); ++rep) {
            const int att_pos = (F.c >> 3) % 3;
#pragma nounroll
            for (int pos = 0; pos < 3; ++pos) {
            if (att_pos == pos) satt_stream(F, l);
            if (pos == 0) { {
                int lane = F.lane; asm volatile("" : "+v"(lane));
                const int cvl = lane & 31, rqi = lane >> 5;
                for (int pg = F.c; pg < 256; pg += F.G) {
                    const int pm = pg >> 2, g = pg & 3, c0 = 256 * g + 8 * cvl;
                    for (int k = 0; k < 4; ++k) { const int rq = 2 * (32 * pm + F.wave + 8 * k) + rqi;
                        if (g == 0) cm_task<2, true>(F, l, rq, c0); else if (g == 1) cm_task<4, true>(F, l, rq, c0); else if (g == 2) cm_task<8, true>(F, l, rq, c0); else cm_task<16, true>(F, l, rq, c0); }
                }
                for (int t = F.c; t < 256; t += F.G) {
                    const int g = (t & 31) >> 3, c0 = 256 * g + 8 * cvl, rq = 2 * (MP / 8 + 8 * (t >> 5) + F.wave) + rqi;
                    if (g == 0) cm_task<2, false>(F, l, rq, c0); else if (g == 1) cm_task<4, false>(F, l, rq, c0); else if (g == 2) cm_task<8, false>(F, l, rq, c0); else cm_task<16, false>(F, l, rq, c0);
                }
            }
            asm volatile("s_waitcnt vmcnt(0)" ::: "memory"); __syncthreads();
            }
            if (pos == 1) { {
                SchedP2 S{F.G, F.c, (const char*)F.z(Z_Q), ws + WS_KB, ws + WS_PS, ws + WS_VT, ws + WS_MIX, ws + WS_PW + (size_t)l * 4 * 256 * 256 * 2};
                Epi<3> E{F, l};
                pg8::gemm_phase(F.lds, 256, DM, 256, S, E);
            }
            small_pool(F, l);
            }
            }
        GRID_BAR();
        }
        for (int rep = 0; rep < (REP_PH == 4 ? 2 : 1); ++rep) {
            SchedP3 S{F.G, F.c, ws + WS_ACONV, ws + WS_WBR + (size_t)l * 3 * DM * DM * 2};
            Epi<4> E{F, l};
            pg8::gemm_phase(F.lds, DM, DM, DM, S, E);
            small_branches(F, l);
        GRID_BAR();
        }
        for (int rep = 0; rep < (REP_PH == 5 ? 2 : 1); ++rep) {
            SchedP4 S{F.G, F.c, ws + WS_MRG, ws + WS_WO + (size_t)l * DM * DM * 2};
            Epi<5> E{F, l, rep};
            pg8::gemm_phase(F.lds, DM, DM, DM, S, E);
            if (rep == 0) small_out(F, l);
        GRID_BAR();
        }
    }
    {
        int lane = F.lane; asm volatile("" : "+v"(lane));
        const int gw = F.vcu * NWAVES + F.wave, NGW = F.G * NWAVES;
        const f32x4* gp = (const f32x4*)F.in[I_FNG] + lane; f32x4 gv[4];
#pragma unroll
        for (int j = 0; j < 4; ++j) gv[j] = gp[64 * j];
        const float* rss = F.rss(DEPTH);
        for (int m0 = 4 * gw; m0 < MT; m0 += 4 * NGW) {
            f32x4 v[4][4]; float rs[4];
#pragma unroll
            for (int r = 0; r < 4; ++r) { rs[r] = rss[m0 + r]; const f32x4* xr = (const f32x4*)(F.out + (size_t)(m0 + r) * DM) + lane;
#pragma unroll
                for (int j = 0; j < 4; ++j) v[r][j] = xr[64 * j]; }
#pragma unroll
            for (int r = 0; r < 4; ++r) { const float rstd = rsqrtf(rs[r] * (1.f / DM) + EPS); f32x4* xr = (f32x4*)(F.out + (size_t)(m0 + r) * DM) + lane;
#pragma unroll
                for (int j = 0; j < 4; ++j) xr[64 * j] = v[r][j] * rstd * gv[j]; }
        }
    }
}

extern "C" void kernel_launch(void* const* d_in, const int* in_sizes, int n_in, void* d_out, int out_size, void* d_ws, size_t ws_size, hipStream_t stream) {
    static int grid = 0;
    if (grid == 0) {
        if (n_in != 19 || (size_t)out_size != O_END || ws_size < WS_END) { fprintf(stderr, "kernel_launch: unexpected shapes: n_in %d out %d ws %zu (need %zu / %zu)\n", n_in, out_size, ws_size, (size_t)O_END, (size_t)WS_END); grid = -1; return; }
        int dev = 0, cus = 0, per_cu = 0;
        if (hipGetDevice(&dev) != hipSuccess || hipDeviceGetAttribute(&cus, hipDeviceAttributeMultiprocessorCount, dev) != hipSuccess) { grid = -1; return; }
        if (hipFuncSetAttribute((const void*)fwd_megakernel, hipFuncAttributeMaxDynamicSharedMemorySize, LDS_BYTES) != hipSuccess) { fprintf(stderr, "kernel_launch: hipFuncSetAttribute failed\n"); grid = -1; return; }
        if (hipOccupancyMaxActiveBlocksPerMultiprocessor(&per_cu, (const void*)fwd_megakernel, NWAVES * 64, LDS_BYTES) != hipSuccess || per_cu < 1) { fprintf(stderr, "kernel_launch: occupancy query says %d blocks per CU\n", per_cu); grid = -1; return; }
        (void)hipGetLastError();
        grid = cus;
    }
    if (grid < 0) return;
    (void)hipMemsetAsync((char*)d_ws + WS_CTL, 0, CTL_ZERO_BYTES, stream);
    Args a{};
    for (int i = 0; i < 19; ++i) a.in[i] = (const float*)d_in[i];
    a.out = (float*)d_out; a.ws = (unsigned char*)d_ws;
    hipLaunchKernelGGL(fwd_megakernel, dim3(grid), dim3(NWAVES * 64), LDS_BYTES, stream, a);
}
```

```cpp
#include <hip/hip_runtime.h>
#include <cstdio>
#ifndef REP_PH
#define REP_PH 0
#endif
#include <cstdint>

#define LAS __attribute__((address_space(3)))
#define GAS __attribute__((address_space(1)))
typedef unsigned short bf16_t;
typedef short bf16x8 __attribute__((ext_vector_type(8)));
typedef float f32x4 __attribute__((ext_vector_type(4)));
typedef float f32x2 __attribute__((ext_vector_type(2)));
typedef unsigned u32x4 __attribute__((ext_vector_type(4)));
typedef unsigned u32x2 __attribute__((ext_vector_type(2)));

constexpr int DM = 1024;
constexpr int NBATCH = 8, SEQ = 2048, DEPTH = 2, DBATCH = 128, DSEQ = 4;
constexpr int MP = NBATCH * SEQ;
constexpr int MS = DBATCH * DSEQ;
constexpr int MT = MP + MS;
constexpr int NMEM = 256, NHEAD = 4, HDIM = 256;
constexpr int DIN = 11 * DM;
constexpr float EPS = 1e-6f;
constexpr float LOG2E = 1.4426950408889634f;

constexpr size_t MiB = 1u << 20;
constexpr size_t SLOT = 33 * MiB;
constexpr size_t WS_CTL = 0, CTL_ZERO_BYTES = 1 * MiB;
constexpr size_t WS_WIN = 1 * MiB;
constexpr size_t WS_WKV = 45 * MiB;
constexpr size_t WS_WBR = 53 * MiB;
constexpr size_t WS_WO = 65 * MiB;
constexpr size_t WS_PW = 69 * MiB;
constexpr size_t WS_HM = 70 * MiB;
constexpr size_t WS_KB = 78 * MiB;
constexpr size_t WS_VT = 82 * MiB;
constexpr size_t WS_XG = 86 * MiB;
constexpr size_t WS_Z = 119 * MiB;
constexpr size_t WS_PS = WS_Z + 9 * SLOT;
constexpr size_t WS_MIX = WS_PS + SLOT;
constexpr size_t WS_ACONV = WS_MIX + SLOT;
constexpr size_t WS_APOOL = WS_ACONV + SLOT;
constexpr size_t WS_AATT = WS_APOOL + SLOT;
constexpr size_t WS_MRG = WS_AATT + SLOT;
constexpr size_t WS_XNEW = WS_MRG + SLOT;
constexpr size_t WS_END = WS_XNEW + 66 * MiB;
enum ZSlot { Z_U = 0, Z_BS, Z_HP, Z_SGP, Z_Q, Z_SGA, Z_SMC, Z_SMP, Z_SMA };
constexpr int CW_BAR = 4096;
constexpr int CW_SP = 12288;
constexpr int CW_FN = 16384;
constexpr int CW_MG = 20480;
constexpr int CW_P2 = 24576;
constexpr int CW_RSS = 32768;

constexpr size_t O_YP = 0;
constexpr size_t O_YS = O_YP + (size_t)MP * DM;
constexpr size_t O_MK = O_YS + (size_t)MS * DM;
constexpr size_t O_MV = O_MK + (size_t)DEPTH * NBATCH * NMEM * DM;
constexpr size_t O_CP = O_MV + (size_t)DEPTH * NBATCH * NMEM * DM;
constexpr size_t O_PP = O_CP + (size_t)DEPTH * NBATCH * 2 * DM;
constexpr size_t O_CS = O_PP + (size_t)DEPTH * NBATCH * 15 * DM;
constexpr size_t O_PSM = O_CS + (size_t)DEPTH * DBATCH * 2 * DM;
constexpr size_t O_END = O_PSM + (size_t)DEPTH * DBATCH * 15 * DM;

constexpr int RING_BYTES = 131072;
constexpr int XTRA_OFF = RING_BYTES, XTRA_BYTES = 8192;
constexpr int MISC_OFF = XTRA_OFF + XTRA_BYTES;
constexpr int LDS_BYTES = 147456;
constexpr int NWAVES = 8;

typedef float f32x2_t __attribute__((ext_vector_type(2)));
typedef __bf16 bf16x2_t __attribute__((ext_vector_type(2)));
__device__ __forceinline__ unsigned cvt_pk_bf16(float lo, float hi) { const f32x2_t v = {lo, hi}; const bf16x2_t b = __builtin_convertvector(v, bf16x2_t); return __builtin_bit_cast(unsigned, b); }
__device__ __forceinline__ float bf_lo(unsigned w) { return __uint_as_float(w << 16); }
__device__ __forceinline__ float bf_hi(unsigned w) { return __uint_as_float(w & 0xffff0000u); }
__device__ __forceinline__ u32x4 pack8(f32x4 a, f32x4 b) { u32x4 w; w.x = cvt_pk_bf16(a[0], a[1]); w.y = cvt_pk_bf16(a[2], a[3]); w.z = cvt_pk_bf16(b[0], b[1]); w.w = cvt_pk_bf16(b[2], b[3]); return w; }
__device__ __forceinline__ u32x2 pack4(f32x4 a) { u32x2 w; w.x = cvt_pk_bf16(a[0], a[1]); w.y = cvt_pk_bf16(a[2], a[3]); return w; }
__device__ __forceinline__ void unpack8(u32x4 w, f32x4& a, f32x4& b) { a = (f32x4){bf_lo(w.x), bf_hi(w.x), bf_lo(w.y), bf_hi(w.y)}; b = (f32x4){bf_lo(w.z), bf_hi(w.z), bf_lo(w.w), bf_hi(w.w)}; }
__device__ __forceinline__ float fast_sigmoid(float x) { return __builtin_amdgcn_rcpf(1.0f + __builtin_amdgcn_exp2f(-LOG2E * x)); }
__device__ __forceinline__ f32x4 sigmoid4(f32x4 v) { return (f32x4){fast_sigmoid(v[0]), fast_sigmoid(v[1]), fast_sigmoid(v[2]), fast_sigmoid(v[3])}; }
__device__ __forceinline__ f32x4 silu4(f32x4 v) { return v * sigmoid4(v); }
__device__ __forceinline__ float wave_sum(float v) {
#pragma unroll
    for (int o = 1; o < 64; o <<= 1) v += __shfl_xor(v, o);
    return v;
}
__device__ __forceinline__ float wave_max(float v) {
#pragma unroll
    for (int o = 1; o < 64; o <<= 1) v = fmaxf(v, __shfl_xor(v, o));
    return v;
}
#define LDS_WAIT() asm volatile("s_waitcnt lgkmcnt(0)" ::: "memory")
#define VM_WAIT() asm volatile("s_waitcnt vmcnt(0)" ::: "memory")

namespace pg8 {
constexpr int BM = 256, BK = 64, HALF = 128, HTB = HALF * BK * 2, STAGE_BYTES = 8 * HTB;
__device__ __forceinline__ int lds_byte(int r, int c) { const int st = (r >> 4) * 2 + (c >> 5), rr = r & 15, cc = c & 31, ob = rr * 64 + cc * 2; return st * 1024 + (ob ^ (((ob >> 9) & 1) << 5)); }
__device__ __forceinline__ void stage_rc(int b, int& R, int& C) { const int st = b / 1024, sb = b % 1024, swz = sb ^ (((sb >> 9) & 1) << 5); R = (st >> 1) * 16 + swz / 64; C = (st & 1) * 32 + (swz % 64) / 2; }
__device__ __forceinline__ int perm32(int rho) { const int n = rho >> 4, i = rho & 15; return 8 * (i >> 2) + 4 * n + (i & 3); }

struct Unit { const char* A; const char* B; int kind, pm, pn, aux; };

template <class Epi, class Sched>
__device__ __forceinline__ void gemm_phase(LAS unsigned char* lds, const int K, const int lda, const int ldb, const Sched& S, const Epi& E) {
    int tid = threadIdx.x; asm volatile("" : "+v"(tid));
    const int wid = __builtin_amdgcn_readfirstlane(tid >> 6), lane = tid & 63, wr = wid >> 2, wc = wid & 3, fr = lane & 15, fq = lane >> 4;
    const int nt = K / BK;
    unsigned voffA[2], voffB[2];
#pragma unroll
    for (int i = 0; i < 2; ++i) { int R, C; stage_rc(tid * 16 + i * 8192, R, C); const int Rb = (R & ~31) + perm32(R & 31);
        voffA[i] = (unsigned)(R * lda + C) * 2u; voffB[i] = (unsigned)(Rb * ldb + C) * 2u; }
    const size_t kstep = (size_t)(BK * 2);
    const size_t hstepA = (size_t)HALF * lda * 2, hstepB = (size_t)HALF * ldb * 2;
    const unsigned ldsw = (unsigned)wid * 1024u;
    const int aoff = lds_byte(wr * 64 + fr, fq * 8), boff = lds_byte(wc * 32 + fr, fq * 8);
#define PG8_SA(b, h) (((b) * 2 + (h)) * HTB)
#define PG8_SB(b, h) ((4 + (b) * 2 + (h)) * HTB)
#define PG8_STAGE(bufoff, gbase, voff) do { _Pragma("unroll") for (int _i = 0; _i < 2; ++_i) \
        __builtin_amdgcn_global_load_lds((const unsigned*)((const char*)(gbase) + (voff)[_i]), (LAS unsigned*)(lds + (bufoff) + ldsw + _i * 8192), 16, 0, 0); } while (0)
#define PG8_LDA(dst, b, h) do { _Pragma("unroll") for (int m = 0; m < 4; ++m) _Pragma("unroll") for (int k = 0; k < 2; ++k) dst[m][k] = *(const LAS bf16x8*)(lds + PG8_SA(b, h) + aoff + m * 2048 + k * 1024); } while (0)
#define PG8_LDB(dst, b, h) do { _Pragma("unroll") for (int n = 0; n < 2; ++n) _Pragma("unroll") for (int k = 0; k < 2; ++k) dst[n][k] = *(const LAS bf16x8*)(lds + PG8_SB(b, h) + boff + n * 2048 + k * 1024); } while (0)
#define PG8_MMA(ai, bj, At, Bt) do { __builtin_amdgcn_s_setprio(1); _Pragma("unroll") for (int m = 0; m < 4; ++m) _Pragma("unroll") for (int n = 0; n < 2; ++n) _Pragma("unroll") for (int k = 0; k < 2; ++k) \
        acc[ai][bj][m][n] = __builtin_amdgcn_mfma_f32_16x16x32_bf16(Bt[n][k], At[m][k], acc[ai][bj][m][n], 0, 0, 0); __builtin_amdgcn_s_setprio(0); } while (0)
#define PG8_WAIT_V(n) asm volatile("s_waitcnt vmcnt(" #n ")" ::: "memory")
#define PG8_WAIT_L(n) asm volatile("s_waitcnt lgkmcnt(" #n ")" ::: "memory")
#define PG8_WAIT_VR(rx) do { if ((rx) >= 16) PG8_WAIT_V(24); else if ((rx) >= 8) PG8_WAIT_V(16); else PG8_WAIT_V(8); } while (0)
#define PG8_BAR __builtin_amdgcn_s_barrier()
#define PG8_SCHED __builtin_amdgcn_sched_barrier(0)
    Unit cur, nxt; int ui = 0, relax = 0;
    if (!S.next(0, cur)) return;
    f32x4 acc[2][2][4][2];
#pragma unroll
    for (int a = 0; a < 2; ++a)
#pragma unroll
        for (int b = 0; b < 2; ++b)
#pragma unroll
            for (int m = 0; m < 4; ++m)
#pragma unroll
                for (int n = 0; n < 2; ++n) acc[a][b][m][n] = (f32x4){0.f, 0.f, 0.f, 0.f};
    bf16x8 At[4][2], B0[2][2], B1[2][2];
    const char* cA = cur.A; const char* cB = cur.B;
    E.prefetch(cur, 0, lds, wid, lane);
    PG8_STAGE(PG8_SB(0, 0), cB, voffB); PG8_STAGE(PG8_SB(0, 1), cB + hstepB, voffB); PG8_STAGE(PG8_SA(0, 0), cA, voffA); PG8_STAGE(PG8_SA(0, 1), cA + hstepA, voffA);
    if (wr == 1) PG8_BAR;
    PG8_WAIT_V(2); PG8_BAR;
    PG8_STAGE(PG8_SB(1, 0), cB + kstep, voffB); PG8_STAGE(PG8_SA(1, 0), cA + kstep, voffA); PG8_STAGE(PG8_SB(1, 1), cB + hstepB + kstep, voffB);
    PG8_WAIT_V(6); PG8_BAR;
    for (;;) {
        const bool has_next = S.next(ui + 1, nxt);
        const char* nA = has_next ? nxt.A : cA; const char* nB = has_next ? nxt.B : cB;
#pragma nounroll
        for (int t = 0; t < nt; t += 2) {
            const bool last = (t == nt - 2); const int rx = (t == 0) ? relax : 0;
            const char* a1 = cA + (size_t)(t + 1) * kstep;
            const char* a2 = last ? nA : cA + (size_t)(t + 2) * kstep; const char* b2 = last ? nB : cB + (size_t)(t + 2) * kstep;
            const char* a3 = a2 + kstep; const char* b3 = b2 + kstep;
            PG8_LDB(B0, 0, 0); PG8_LDB(B1, 0, 1); PG8_SCHED; PG8_LDA(At, 0, 0); PG8_STAGE(PG8_SA(1, 1), a1 + hstepA, voffA);
            PG8_WAIT_VR(rx); PG8_WAIT_L(0); PG8_BAR; PG8_MMA(0, 0, At, B0); PG8_MMA(0, 1, At, B1); PG8_BAR; PG8_SCHED;
            PG8_LDA(At, 0, 1); PG8_STAGE(PG8_SB(0, 0), b2, voffB); PG8_STAGE(PG8_SB(0, 1), b2 + hstepB, voffB); PG8_STAGE(PG8_SA(0, 0), a2, voffA);
            PG8_WAIT_VR(rx); PG8_WAIT_L(0); PG8_BAR; PG8_MMA(1, 0, At, B0); PG8_MMA(1, 1, At, B1); PG8_BAR; PG8_SCHED;
            PG8_LDB(B0, 1, 0); PG8_LDB(B1, 1, 1); PG8_SCHED; PG8_LDA(At, 1, 0); PG8_STAGE(PG8_SA(0, 1), a2 + hstepA, voffA);
            PG8_WAIT_V(8); PG8_WAIT_L(0); PG8_BAR; PG8_MMA(0, 0, At, B0); PG8_MMA(0, 1, At, B1); PG8_BAR; PG8_SCHED;
            PG8_LDA(At, 1, 1); PG8_STAGE(PG8_SB(1, 0), b3, voffB); PG8_STAGE(PG8_SB(1, 1), b3 + hstepB, voffB); PG8_STAGE(PG8_SA(1, 0), a3, voffA);
            PG8_WAIT_V(8); PG8_WAIT_L(0); PG8_BAR; PG8_MMA(1, 0, At, B0); PG8_MMA(1, 1, At, B1); PG8_BAR; PG8_SCHED;
        }
        if (wr == 0) PG8_BAR;
        E(acc, cur, wr, wc, fr, fq, lds, ui);
        if (!has_next) break;
        if (!E.keep_acc(cur)) {
#pragma unroll
        for (int a = 0; a < 2; ++a)
#pragma unroll
            for (int b = 0; b < 2; ++b)
#pragma unroll
                for (int m = 0; m < 4; ++m)
#pragma unroll
                    for (int n = 0; n < 2; ++n) acc[a][b][m][n] = (f32x4){0.f, 0.f, 0.f, 0.f};
        }
        relax = E.stores_lb(cur);
        cur = nxt; cA = nA; cB = nB; ++ui;
        E.prefetch(cur, ui, lds, wid, lane);
        if (wr == 1) PG8_BAR;
    }
    PG8_WAIT_V(0);
    PG8_BAR;
#undef PG8_SA
#undef PG8_SB
#undef PG8_STAGE
#undef PG8_LDA
#undef PG8_LDB
#undef PG8_MMA
#undef PG8_WAIT_V
#undef PG8_WAIT_L
#undef PG8_WAIT_VR
#undef PG8_BAR
#undef PG8_SCHED
}
template <int WGM = 8> __device__ __forceinline__ void tile_remap(int L, int nM, int nN, int& pm, int& pn) {
    const int nwg = nM * nN; int wgid = L;
    { const int q = nwg / 8, r = nwg % 8, xcd = wgid % 8, off = wgid / 8; wgid = (xcd < r ? xcd * (q + 1) : r * (q + 1) + (xcd - r) * q) + off; }
    const int nig = WGM * nN, gid = wgid / nig, fm = gid * WGM, gsz = (nM - fm) < WGM ? (nM - fm) : WGM;
    pm = fm + ((wgid % nig) % gsz); pn = (wgid % nig) / gsz;
}
}

#define XB_TMO      128
#define XB_XCNT(j)  (256  + 64 * (j))
#define XB_XSUB(j)  (1280 + 64 * (j))
#define XB_XGEN(j)  (2304 + 64 * (j))
#define XB_TOP      3328
#define XB_TOPGEN   3392
#define XCD_BAR_WORDS 3456
#define XB_SPIN_CAP (1u << 18)
__device__ __forceinline__ unsigned xb_ld(unsigned* p)              { return __hip_atomic_load(p, __ATOMIC_RELAXED, __HIP_MEMORY_SCOPE_AGENT); }
__device__ __forceinline__ unsigned xb_add(unsigned* p, unsigned v) { return __hip_atomic_fetch_add(p, v, __ATOMIC_RELAXED, __HIP_MEMORY_SCOPE_AGENT); }
__device__ __forceinline__ unsigned xb_xcc_id() { return (unsigned)__builtin_amdgcn_s_getreg((3 << 11) | 20) & 0xFu; }
#define XB_SPIN(cond, bar) do { unsigned _sp = 0; while (cond) { __builtin_amdgcn_s_sleep(1); \
    if ((++_sp & 255u) == 0u) { if (xb_ld(&(bar)[XB_TMO])) break; if (_sp > XB_SPIN_CAP) { atomicAdd(&(bar)[XB_TMO], 1u); break; } } } } while (0)
struct XcdBarrier { unsigned* bar; unsigned x; volatile LAS unsigned* st; };
__device__ __forceinline__ XcdBarrier xcd_barrier_post(unsigned* bar, volatile LAS unsigned* st) {
    XcdBarrier b; b.bar = bar; b.x = xb_xcc_id(); b.st = st;
    if (threadIdx.x == 0) (void)xb_add(&bar[XB_XCNT(b.x)], 1u);
    return b;
}
__device__ __forceinline__ void xcd_barrier_complete(unsigned* bar, unsigned x, unsigned& nloc, unsigned& nx) {
    const unsigned G = gridDim.x * gridDim.y * gridDim.z;
    unsigned sum, cnt, mine, sp = 0u;
    for (;;) {
        sum = 0u; cnt = 0u; mine = 0u;
#pragma unroll
        for (unsigned j = 0; j < 16; ++j) { const unsigned c = xb_ld(&bar[XB_XCNT(j)]); sum += c; cnt += (c > 0u) ? 1u : 0u; mine = (j == x) ? c : mine; }
        if (sum == G) break;
        __builtin_amdgcn_s_sleep(1);
        if ((++sp & 255u) == 0u) { if (xb_ld(&bar[XB_TMO])) break; if (sp > XB_SPIN_CAP) { atomicAdd(&bar[XB_TMO], 1u); break; } }
    }
    nloc = mine > 0u ? mine : 1u; nx = cnt > 0u ? cnt : 1u;
}
__device__ __forceinline__ void xcd_barrier(const XcdBarrier& b) {
    asm volatile("s_waitcnt vmcnt(0)" ::: "memory");
    __syncthreads();
    if (threadIdx.x == 0) {
        unsigned* bar = b.bar;
        __builtin_amdgcn_s_waitcnt(0);
        unsigned nloc = b.st[0], nx = b.st[1];
        if (nloc == 0u) { xcd_barrier_complete(bar, b.x, nloc, nx); b.st[0] = nloc; b.st[1] = nx; }
        const unsigned old = xb_add(&bar[XB_XSUB(b.x)], 1u);
        const unsigned gen = old / nloc;
        if (old + 1u == (gen + 1u) * nloc) {
            __builtin_amdgcn_fence(__ATOMIC_RELEASE, "agent");
            asm volatile("s_waitcnt vmcnt(0)" ::: "memory");
            const unsigned og = xb_add(&bar[XB_TOP], 1u);
            const unsigned tg = og / nx;
            if (og + 1u == (tg + 1u) * nx) xb_add(&bar[XB_TOPGEN], 1u);
            else XB_SPIN(xb_ld(&bar[XB_TOPGEN]) == tg, bar);
            __builtin_amdgcn_fence(__ATOMIC_ACQUIRE, "agent");
            xb_add(&bar[XB_XGEN(b.x)], 1u);
            asm volatile("s_waitcnt vmcnt(0)" ::: "memory");
        } else {
            XB_SPIN(xb_ld(&bar[XB_XGEN(b.x)]) == gen, bar);
            __builtin_amdgcn_fence(__ATOMIC_ACQUIRE, "agent");
            asm volatile("s_waitcnt vmcnt(0)" ::: "memory");
        }
    }
    __syncthreads();
}

struct Args { const float* in[19]; float* out; unsigned char* ws; };
enum In { I_XP = 0, I_XS, I_MEM, I_CK, I_CV, I_SCONV, I_SPOOL, I_NG, I_WIN, I_CONVW, I_POOLW, I_PSCALE, I_MNG, I_WKV, I_WBC, I_WBP, I_WBA, I_WOUT, I_FNG };
enum Kind { K_Z = 0, K_KV, K_VT, K_S, K_O, K_POOL, K_BR, K_OUT };

struct Ctx {
    const float* in[19]; float* out; unsigned char* ws;
    LAS unsigned char* lds;
    int tid, lane, wave, G, c, vcu;
    __device__ __forceinline__ bf16_t* z(int slot) const { return (bf16_t*)(ws + WS_Z + (size_t)slot * SLOT); }
    __device__ __forceinline__ float* rss(int i) const { return (float*)(ws + WS_CTL) + CW_RSS + i * 32768; }
};

__device__ __forceinline__ int win_src_col(int np) {
    const int tile = np >> 8, i = np & 255;
    if (tile < 8) return (i < 128) ? (128 * tile + i) : (2 * DM + 128 * tile + (i - 128));
    if (tile < 16) { const int p = tile - 8; return (i < 128) ? (DM + 128 * p + i) : (3 * DM + 128 * p + (i - 128)); }
    return np;
}

__device__ __forceinline__ int gate_dst_row(int sel, int c) {
    const int t = c >> 6, wc = (c >> 4) & 3, fq = (c >> 2) & 3, j = c & 3;
    const int bj = (sel == 0 || sel == 3) ? 1 : 0, n = (sel == 0 || sel == 2) ? 1 : 0;
    return 256 * (28 + t) + 128 * bj + 32 * wc + 8 * fq + 4 * n + j;
}
template <bool SCALE = false, bool GATE = false>
__device__ __forceinline__ void p0_transpose_item(const float* W, int ldw, int srccol0, int k0, bf16_t* WT, int ldt, int dstrow0, LAS float* scr, int lane, const float* gk = nullptr, int gsel = 0) {
    f32x4 wv[8];
#pragma unroll
    for (int i = 0; i < 8; ++i) wv[i] = *(const f32x4*)(W + (size_t)(k0 + 8 * i + (lane >> 3)) * ldw + srccol0 + 4 * (lane & 7));
    if constexpr (SCALE) { float gv[8];
#pragma unroll
        for (int i = 0; i < 8; ++i) gv[i] = gk[k0 + 8 * i + (lane >> 3)];
#pragma unroll
        for (int i = 0; i < 8; ++i) wv[i] *= gv[i]; }
#pragma unroll
    for (int i = 0; i < 8; ++i)
#pragma unroll
        for (int e = 0; e < 4; ++e) scr[(8 * i + (lane >> 3)) * 33 + 4 * (lane & 7) + e] = wv[i][e];
    LDS_WAIT(); asm volatile("" ::: "memory");
    const int c = lane & 7;
#pragma unroll
    for (int j = 0; j < 4; ++j) { const int n = (lane >> 3) + 8 * j; const LAS float* s = scr + (8 * c) * 33 + n;
        u32x4 o; o.x = cvt_pk_bf16(s[0 * 33], s[1 * 33]); o.y = cvt_pk_bf16(s[2 * 33], s[3 * 33]); o.z = cvt_pk_bf16(s[4 * 33], s[5 * 33]); o.w = cvt_pk_bf16(s[6 * 33], s[7 * 33]);
        const int drow = GATE ? gate_dst_row(gsel, dstrow0 + n) : dstrow0 + n;
        *(u32x4*)(WT + (size_t)drow * ldt + k0 + 8 * c) = o; }
    LDS_WAIT(); asm volatile("" ::: "memory");
}

constexpr int XI_LATE = 16 * (DIN / 32);
constexpr int XI_OWN = 16 * (DIN / 32) + 16 * 64;
constexpr int XI_IN = 16 * (DIN / 32), XI_KV = 16 * 64, XI_BR = 16 * 32, XI_PWG = 4 * 8, XI_PER_LAYER = XI_IN + XI_KV + 4 * XI_BR + 4 * XI_PWG;
__device__ __forceinline__ void convert_weights(const Ctx& F, int item0, int item1, int gw, int NGW) {
    LAS float* scr = (LAS float*)(F.lds + F.wave * 16384);
    int lane = F.lane; asm volatile("" : "+v"(lane));
    gw = __builtin_amdgcn_readfirstlane(gw); asm volatile("" : "+s"(gw));
    constexpr int I_IN = XI_IN, I_KV = XI_KV, I_BR = XI_BR, I_PWG = XI_PWG, PER_LAYER = XI_PER_LAYER;
    struct XItem { const float* W; bf16_t* WT; const float* gk; int ldw, ldt, dstrow0, gsel; };
    auto decode = [&](int it, XItem& X) -> bool {
        if (it >= item1) return false;
        const int l = it / PER_LAYER; int r = it % PER_LAYER;
        X.gk = nullptr; X.gsel = -1; X.ldt = DM;
        if (r < I_IN) { const int kb = r / (DIN / 32), nb = r % (DIN / 32); const float* Wl = F.in[I_WIN] + (size_t)l * DM * DIN + (size_t)(64 * kb) * DIN;
            X.ldw = DIN; X.gk = F.in[I_NG] + (size_t)l * DM + 64 * kb; X.WT = (bf16_t*)(F.ws + WS_WIN) + (size_t)l * DIN * DM + 64 * kb;
            if (nb >= 7168 / 32) { const int sc = 32 * nb - 7168; X.W = Wl + 32 * nb; X.dstrow0 = sc & 1023; X.gsel = sc >> 10; }
            else { X.W = Wl + win_src_col(32 * nb); X.dstrow0 = 32 * nb; }
            return true; }
        r -= I_IN;
        if (r < I_KV) { const int kb = r / 64, nb = r % 64; X.ldw = 2048; X.W = F.in[I_WKV] + (size_t)l * DM * 2048 + (size_t)(64 * kb) * 2048 + 32 * nb; X.WT = (bf16_t*)(F.ws + WS_WKV) + (size_t)l * 2048 * DM + 64 * kb; X.dstrow0 = 32 * nb; return true; }
        r -= I_KV;
        if (r < 4 * I_BR) { const int wsel = r / I_BR, rr = r % I_BR, kb = rr / 32, nb = rr % 32; X.ldw = DM;
            const float* Wb; bf16_t* Tb;
            if (wsel == 0) { Wb = F.in[I_WBC]; Tb = (bf16_t*)(F.ws + WS_WBR) + ((size_t)l * 3 + 0) * DM * DM; }
            else if (wsel == 1) { Wb = F.in[I_WBP]; Tb = (bf16_t*)(F.ws + WS_WBR) + ((size_t)l * 3 + 1) * DM * DM; }
            else if (wsel == 2) { Wb = F.in[I_WBA]; Tb = (bf16_t*)(F.ws + WS_WBR) + ((size_t)l * 3 + 2) * DM * DM; }
            else { Wb = F.in[I_WOUT]; Tb = (bf16_t*)(F.ws + WS_WO) + (size_t)l * DM * DM; }
            X.W = Wb + (size_t)l * DM * DM + (size_t)(64 * kb) * DM + 32 * nb; X.WT = Tb + 64 * kb; X.dstrow0 = 32 * nb; return true; }
        r -= 4 * I_BR;
        { const int g = r / I_PWG, rr = r % I_PWG, kb = rr / 8, nb = rr % 8;
          X.ldw = 256; X.ldt = 256; X.W = F.in[I_POOLW] + ((size_t)l * 4 + g) * 256 * 256 + (size_t)(64 * kb) * 256 + 32 * nb; X.WT = (bf16_t*)(F.ws + WS_PW) + ((size_t)l * 4 + g) * 256 * 256 + 64 * kb; X.dstrow0 = 32 * nb; }
        return true;
    };
    auto xload = [&](const XItem& X, f32x4 (&wv)[8], float (&gv)[8]) {
#pragma unroll
        for (int i = 0; i < 8; ++i) wv[i] = *(const f32x4*)(X.W + (size_t)(8 * i + (lane >> 3)) * X.ldw + 4 * (lane & 7));
#pragma unroll
        for (int i = 0; i < 8; ++i) gv[i] = X.gk ? X.gk[8 * i + (lane >> 3)] : 1.0f;
    };
    auto xfinish = [&](const XItem& X, const f32x4 (&wv)[8], const float (&gv)[8]) {
#pragma unroll
        for (int i = 0; i < 8; ++i)
#pragma unroll
            for (int e = 0; e < 4; ++e) scr[(8 * i + (lane >> 3)) * 33 + 4 * (lane & 7) + e] = wv[i][e] * gv[i];
        LDS_WAIT(); asm volatile("" ::: "memory");
        const int c = lane & 7;
#pragma unroll
        for (int j = 0; j < 4; ++j) { const int n = (lane >> 3) + 8 * j; const LAS float* s = scr + (8 * c) * 33 + n;
            u32x4 o; o.x = cvt_pk_bf16(s[0 * 33], s[1 * 33]); o.y = cvt_pk_bf16(s[2 * 33], s[3 * 33]); o.z = cvt_pk_bf16(s[4 * 33], s[5 * 33]); o.w = cvt_pk_bf16(s[6 * 33], s[7 * 33]);
            const int drow = (X.gsel >= 0) ? gate_dst_row(X.gsel, X.dstrow0 + n) : X.dstrow0 + n;
            *(u32x4*)(X.WT + (size_t)drow * X.ldt + 8 * c) = o; }
        LDS_WAIT(); asm volatile("" ::: "memory");
    };
    {
        XItem cur, nxt; f32x4 wv[8], wn[8]; float gv[8], gn[8];
        int it = item0 + gw; bool has = decode(it, cur);
        if (has) xload(cur, wv, gv);
        while (has) {
            it += NGW;
            const bool hn = decode(it, nxt);
            if (hn) xload(nxt, wn, gn);
            __builtin_amdgcn_sched_barrier(0);
            xfinish(cur, wv, gv);
            cur = nxt; has = hn;
#pragma unroll
            for (int i = 0; i < 8; ++i) { wv[i] = wn[i]; gv[i] = gn[i]; }
        }
    }
}

__device__ __forceinline__ void p0_prologue(const Ctx& F) {
    LAS float* scr = (LAS float*)(F.lds + F.wave * 16384);
    const int gw = F.vcu * NWAVES + F.wave, NGW = F.G * NWAVES, lane = F.lane;
    convert_weights(F, 0, XI_PER_LAYER, gw, NGW);
#pragma nounroll
    for (int l = 1; l < DEPTH; ++l) convert_weights(F, l * XI_PER_LAYER + XI_LATE, l * XI_PER_LAYER + XI_OWN, gw, NGW);
    {
        float* rss0 = F.rss(0);
        for (int m0 = 4 * gw; m0 < MT; m0 += 4 * NGW) {
            f32x4 v[4][4];
#pragma unroll
            for (int r = 0; r < 4; ++r) { const int m = m0 + r;
                const f32x4* xr = (const f32x4*)((m < MP) ? F.in[I_XP] + (size_t)m * DM : F.in[I_XS] + (size_t)(m - MP) * DM) + lane;
#pragma unroll
                for (int j = 0; j < 4; ++j) v[r][j] = xr[64 * j]; }
#pragma unroll
            for (int r = 0; r < 4; ++r) { const int m = m0 + r; float s = 0.f;
#pragma unroll
                for (int j = 0; j < 4; ++j) s += (v[r][j].x * v[r][j].x + v[r][j].y * v[r][j].y) + (v[r][j].z * v[r][j].z + v[r][j].w * v[r][j].w);
                s = wave_sum(s);
                if (lane == 0) rss0[m] = s;
                u32x2* o8 = (u32x2*)((bf16_t*)(F.ws + WS_XG) + (size_t)m * DM) + lane;
#pragma unroll
                for (int j = 0; j < 4; ++j) { const f32x4 y = v[r][j]; u32x2 w; w.x = cvt_pk_bf16(y.x, y.y); w.y = cvt_pk_bf16(y.z, y.w); o8[64 * j] = w; } }
        }
    }
    for (int m = gw; m < NBATCH * NMEM; m += NGW) {
        const f32x4* xr = (const f32x4*)(F.in[I_MEM] + (size_t)m * DM) + lane;
        f32x4 v[4], g0[4], g1[4]; float s = 0.f;
#pragma unroll
        for (int j = 0; j < 4; ++j) { v[j] = xr[64 * j]; g0[j] = ((const f32x4*)F.in[I_MNG] + lane)[64 * j]; g1[j] = ((const f32x4*)(F.in[I_MNG] + DM) + lane)[64 * j]; }
#pragma unroll
        for (int j = 0; j < 4; ++j) s += (v[j].x * v[j].x + v[j].y * v[j].y) + (v[j].z * v[j].z + v[j].w * v[j].w);
        const float rstd = rsqrtf(wave_sum(s) * (1.f / DM) + EPS);
        u32x2* o0 = (u32x2*)((bf16_t*)(F.ws + WS_HM) + (size_t)m * DM) + lane;
        u32x2* o1 = (u32x2*)((bf16_t*)(F.ws + WS_HM) + ((size_t)NBATCH * NMEM + m) * DM) + lane;
#pragma unroll
        for (int j = 0; j < 4; ++j) { const f32x4 y0 = v[j] * rstd * g0[j], y1 = v[j] * rstd * g1[j]; u32x2 w;
            w.x = cvt_pk_bf16(y0.x, y0.y); w.y = cvt_pk_bf16(y0.z, y0.w); o0[64 * j] = w; w.x = cvt_pk_bf16(y1.x, y1.y); w.y = cvt_pk_bf16(y1.z, y1.w); o1[64 * j] = w; }
    }
}
__device__ __forceinline__ void pool_state_copy(const Ctx& F, int gi, int gn) {
    int tid = F.tid; asm volatile("" : "+v"(tid));
    const size_t n4 = (size_t)DEPTH * DBATCH * 11 * (DM / 4), st = (size_t)gn * 512;
    for (size_t i0 = (size_t)gi * 512 + tid; i0 < n4; i0 += 4 * st) {
        f32x4 v[4];
#pragma unroll
        for (int q = 0; q < 4; ++q) { const size_t i = i0 + q * st; if (i < n4) { const size_t c4 = i % (DM / 4), rowi = i / (DM / 4), k = rowi % 11, lb = rowi / 11; v[q] = ((const f32x4*)F.in[I_SPOOL])[(lb * 15 + 4 + k) * (DM / 4) + c4]; } }
#pragma unroll
        for (int q = 0; q < 4; ++q) { const size_t i = i0 + q * st; if (i < n4) { const size_t c4 = i % (DM / 4), rowi = i / (DM / 4), k = rowi % 11, lb = rowi / 11; ((f32x4*)(F.out + O_PSM))[(lb * 15 + k) * (DM / 4) + c4] = v[q]; } }
    }
}

constexpr size_t TILEB = (size_t)256 * DM * 2;
struct SchedP1 {
    int G, c; const char *XG, *WinT, *HM, *WkvT;
    __device__ __forceinline__ bool next(int i, pg8::Unit& u) const {
        const int L0 = i * G + c;
        if (L0 >= 3000) return false;
        const int L = (L0 < 96) ? 2904 + L0 : L0 - 96;
        if (L < 2904) { int pm, pn;
            if (L < 1056) { pg8::tile_remap<6>(L, 66, 16, pm, pn); pn = 43 - pn; } else { pg8::tile_remap<6>(L - 1056, 66, 28, pm, pn); pn = 27 - pn; }
            u.kind = K_Z; u.pm = pm; u.pn = pn; u.aux = 0; u.A = XG + (size_t)pm * TILEB; u.B = WinT + (size_t)pn * TILEB; return true; }
        if (L < 2968) { const int t = L - 2904; u.kind = K_KV; u.pm = t >> 3; u.pn = t & 7; u.aux = 0; u.A = HM + (size_t)u.pm * TILEB; u.B = WkvT + (size_t)u.pn * TILEB; return true; }
        if (L < 3000) { const int t = L - 2968; u.kind = K_VT; u.pm = t >> 3; u.pn = t & 7; u.aux = 0; u.A = WkvT + (size_t)(4 + u.pm) * TILEB; u.B = HM + (size_t)u.pn * TILEB; return true; }
        return false;
    }
};
struct SchedP2 {
    int G, c; const char *Q, *KB, *PS, *VT, *MIX, *PwT;
    __device__ __forceinline__ bool next(int i, pg8::Unit& u) const {
        const int r = i / 3, ph = i - 3 * r, L = r * G + c; if (L >= 256) return false;
        const int b = L & 7, idx = L >> 3, j = idx & 7, h = idx >> 3;
        if (ph == 1) { u.kind = K_POOL; u.pm = L >> 2; u.pn = L & 3; u.aux = 0;
            u.A = MIX + ((size_t)u.pm * 256 * DM + 256 * u.pn) * 2; u.B = PwT + (size_t)u.pn * 256 * 256 * 2; return true; }
        u.pm = b * 8 + j; u.pn = h; u.aux = 0;
        if (ph == 0) { u.kind = K_S; u.A = Q + ((size_t)u.pm * 256 * DM + 256 * h) * 2; u.B = KB + ((size_t)(b * NHEAD + h) * NMEM * HDIM) * 2; }
        else { u.kind = K_O; u.A = PS + ((size_t)u.pm * 256 * DM + 256 * h) * 2; u.B = VT + ((size_t)b * DM * 256 + (size_t)256 * h * 256) * 2; }
        return true;
    }
};
struct SchedP3 {
    int G, c; const char *AC, *Wbr;
    __device__ __forceinline__ bool next(int i, pg8::Unit& u) const {
        const int tr = i / 3, br = i - 3 * tr, L = tr * G + c; if (L >= 256) return false;
        int pm, pn; pg8::tile_remap(L, 64, 4, pm, pn); u.kind = K_BR; u.pm = pm; u.pn = pn; u.aux = br;
        u.A = AC + (size_t)br * SLOT + (size_t)pm * TILEB; u.B = Wbr + ((size_t)br * DM + 256 * pn) * DM * 2; return true;
    }
};
struct SchedP4 {
    int G, c; const char *MRG, *Wo;
    __device__ __forceinline__ bool next(int i, pg8::Unit& u) const {
        const int L = i * G + c; if (L >= 256) return false;
        int pm, pn; pg8::tile_remap(L, 64, 4, pm, pn); u.kind = K_OUT; u.pm = pm; u.pn = pn; u.aux = 0;
        u.A = MRG + (size_t)pm * TILEB; u.B = Wo + (size_t)pn * TILEB; return true;
    }
};

#define GP(T, base, off) ((T*)((char*)(base) + (unsigned)(off)))
#define GPC(T, base, off) ((const T*)((const char*)(base) + (unsigned)(off)))
__device__ __forceinline__ void wt_store16(unsigned char* ws, const void* p, u32x4 v) {
    const __amdgpu_buffer_rsrc_t r = __builtin_amdgcn_make_buffer_rsrc(ws, 0, 0x7fffffff, 0x00027000);
    __builtin_amdgcn_raw_buffer_store_b128(v, r, (int)(unsigned)((const unsigned char*)p - ws), 0, 16);
}
__device__ __forceinline__ void wt_store16o(unsigned char* ws, unsigned uoff, unsigned loff, u32x4 v) {
    const __amdgpu_buffer_rsrc_t r = __builtin_amdgcn_make_buffer_rsrc(ws, 0, 0x7fffffff, 0x00027000);
    __builtin_amdgcn_raw_buffer_store_b128(v, r, (int)loff, (int)uoff, 16);
}
__device__ __forceinline__ void wt_store8(unsigned char* ws, const void* p, u32x2 v) {
    const __amdgpu_buffer_rsrc_t r = __builtin_amdgcn_make_buffer_rsrc(ws, 0, 0x7fffffff, 0x00027000);
    __builtin_amdgcn_raw_buffer_store_b64(v, r, (int)(unsigned)((const unsigned char*)p - ws), 0, 16);
}
template <int PH> struct Epi {
    __device__ __forceinline__ bool keep_acc(const pg8::Unit& u) const { return PH == 4 && u.aux < 2; }
    Ctx F; int l; int rep = 0; bool fuse_fn = false; bool handoff = false;
    __device__ __forceinline__ int stores_lb(const pg8::Unit& u) const {
        if constexpr (PH == 1) { if (u.kind == K_Z) return (u.pn < 16) ? 8 : ((u.pm >= 64 && u.pn >= 24 && u.pn < 32) ? 0 : 16); return 16; }
        return 0;
    }
    __device__ __forceinline__ void prefetch(const pg8::Unit& u, int ui, LAS unsigned char* lds, int wid, int lane) const {
        if constexpr (PH == 1) {
            if (u.kind == K_Z && wid == 0) {
                const float* rss = F.rss(l) + u.pm * 256 + lane;
#pragma unroll
                for (int i = 0; i < 4; ++i) __builtin_amdgcn_global_load_lds((const unsigned*)(rss + 64 * i), (LAS unsigned*)(lds + XTRA_OFF + (ui & 1) * 1024 + i * 256), 4, 0, 0);
            }
        }
    }
    __device__ __forceinline__ void operator()(f32x4 (&acc)[2][2][4][2], const pg8::Unit& u, int wr, int wc, int fr, int fq, LAS unsigned char* lds, int ui) const {
        unsigned rl = (unsigned)(wr * 64 + fr), cl = (unsigned)(wc * 32 + 8 * fq);
        asm volatile("" : "+v"(rl), "+v"(cl));
        const unsigned lo2 = (rl * DM + cl) * 2u, lo4 = (rl * DM + cl) * 4u;
        constexpr unsigned RS2 = 16u * DM * 2u, AS2 = 128u * DM * 2u, RS4 = 16u * DM * 4u, AS4 = 128u * DM * 4u;
        if constexpr (PH == 1) {
            if (u.kind == K_Z) {
                const unsigned row0 = (unsigned)u.pm * 256u + rl;
                float rsv[2][4];
                const LAS float* rsl = (const LAS float*)(lds + XTRA_OFF + (ui & 1) * 1024);
#pragma unroll
                for (int ai = 0; ai < 2; ++ai)
#pragma unroll
                    for (int m = 0; m < 4; ++m) rsv[ai][m] = rsl[rl + 128 * ai + 16 * m];
#pragma unroll
                for (int ai = 0; ai < 2; ++ai)
#pragma unroll
                    for (int m = 0; m < 4; ++m) rsv[ai][m] = rsqrtf(rsv[ai][m] * (1.f / DM) + EPS);
                if (u.pn < 8) {
                    const int p = u.pn;
                    char* dst = (char*)(F.z(Z_U) + (size_t)u.pm * 256 * DM + 128 * p);
#pragma unroll
                    for (int ai = 0; ai < 2; ++ai)
#pragma unroll
                        for (int m = 0; m < 4; ++m) {
                            const float rs2 = rsv[ai][m] * rsv[ai][m];
                            const f32x4 o0 = acc[ai][0][m][0] * acc[ai][1][m][0] * rs2, o1 = acc[ai][0][m][1] * acc[ai][1][m][1] * rs2;
                            *GP(u32x4, dst, lo2 + ai * AS2 + m * RS2) = pack8(o0, o1);
                            const unsigned row = row0 + 128 * ai + 16 * m; unsigned oo = 0xffffffffu;
                            if (row < (unsigned)MP) { const unsigned t = row & (SEQ - 1); if (t >= SEQ - 2) oo = (unsigned)(O_CP + (((size_t)l * NBATCH + (row >> 11)) * 2 + (t - (SEQ - 2))) * DM); }
                            else { const unsigned rs_ = row - MP, t = rs_ & 3; if (t >= 2) oo = (unsigned)(O_CS + (((size_t)l * DBATCH + (rs_ >> 2)) * 2 + (t - 2)) * DM); }
                            if (oo != 0xffffffffu) { oo = (oo + 128 * p + cl) * 4u; *GP(f32x4, F.out, oo) = o0; *GP(f32x4, F.out, oo + 16) = o1; }
                            asm volatile("" ::: "memory");
                        }
                } else if (u.pn < 16) {
                    const int p = u.pn - 8;
                    char* dst = (char*)(F.z(Z_BS) + (size_t)u.pm * 256 * DM + 128 * p);
#pragma unroll
                    for (int ai = 0; ai < 2; ++ai)
#pragma unroll
                        for (int m = 0; m < 4; ++m) {
                            const float rs2 = rsv[ai][m] * rsv[ai][m], nrs = -LOG2E * rsv[ai][m];
                            f32x4 o[2];
#pragma unroll
                            for (int n = 0; n < 2; ++n)
#pragma unroll
                                for (int j = 0; j < 4; ++j) { const float g = acc[ai][1][m][n][j]; o[n][j] = (acc[ai][0][m][n][j] * g * rs2) * __builtin_amdgcn_rcpf(1.0f + __builtin_amdgcn_exp2f(g * nrs)); }
                            *GP(u32x4, dst, lo2 + ai * AS2 + m * RS2) = pack8(o[0], o[1]);
                            asm volatile("" ::: "memory");
                        }
                } else if (u.pn >= 28) {
                    char* dc = (char*)(F.z(Z_SMC) + (size_t)u.pm * 256 * DM + 64 * (u.pn - 28));
                    const unsigned odd = (cl >> 3) & 1u, lom = rl * (DM * 2u) + (cl & ~8u);
                    const unsigned o0 = lom + odd * (unsigned)SLOT, o1 = lom + (1u - odd) * (unsigned)(3 * SLOT);
#pragma unroll
                    for (int ai = 0; ai < 2; ++ai)
#pragma unroll
                        for (int m = 0; m < 4; ++m) {
                            const float rs = rsv[ai][m], nrs = -LOG2E * rs;
                            f32x4 r1, r2, ga, sg;
#pragma unroll
                            for (int j = 0; j < 4; ++j) {
                                const float ec = 1.0f + __builtin_amdgcn_exp2f(acc[ai][0][m][0][j] * nrs)  , ep = 1.0f + __builtin_amdgcn_exp2f(fminf(acc[ai][0][m][1][j] * nrs, 60.f));
                                const float ea = 1.0f + __builtin_amdgcn_exp2f(fminf(acc[ai][1][m][0][j] * nrs, 60.f)), zs = acc[ai][1][m][1][j];
                                const float ip = __builtin_amdgcn_rcpf(ep); ga[j] = __builtin_amdgcn_rcpf(ea);
                                r1[j] = ep * __builtin_amdgcn_rcpf(ec); r2[j] = ea * ip; sg[j] = (zs * rs) * __builtin_amdgcn_rcpf(1.0f + __builtin_amdgcn_exp2f(zs * nrs)); }
                            const u32x2 p1 = pack4(r1), p2 = pack4(r2), pa = pack4(ga), ps = pack4(sg);
                            const auto s0 = __builtin_amdgcn_permlane16_swap(p1.x, p2.x, false, false), s1 = __builtin_amdgcn_permlane16_swap(p1.y, p2.y, false, false);
                            const auto s2 = __builtin_amdgcn_permlane16_swap(pa.x, ps.x, false, false), s3 = __builtin_amdgcn_permlane16_swap(pa.y, ps.y, false, false);
                            *GP(u32x4, dc, o0 + ai * AS2 + m * RS2) = (u32x4){s0[0], s1[0], s0[1], s1[1]};
                            *GP(u32x4, dc - SLOT, o1 + ai * AS2 + m * RS2) = (u32x4){s2[0], s3[0], s2[1], s3[1]};
                            asm volatile("" ::: "memory");
                        }
                } else {
                    const int slot = Z_HP + ((u.pn - 16) >> 2), cb = 256 * ((u.pn - 16) & 3);
                    char* dst = (char*)(F.z(slot) + (size_t)u.pm * 256 * DM + cb);
                    if (slot == Z_HP) {
#pragma unroll
                        for (int ai = 0; ai < 2; ++ai)
#pragma unroll
                            for (int m = 0; m < 4; ++m) {
                                const float rs = rsv[ai][m];
                                const unsigned row = row0 + 128 * ai + 16 * m; unsigned oo = 0xffffffffu;
                                if (row < (unsigned)MP) { const unsigned t = row & (SEQ - 1); if (t >= SEQ - 15) oo = (unsigned)(O_PP + (((size_t)l * NBATCH + (row >> 11)) * 15 + (t - (SEQ - 15))) * DM); }
                                else { const unsigned rs_ = row - MP; oo = (unsigned)(O_PSM + (((size_t)l * DBATCH + (rs_ >> 2)) * 15 + 11 + (rs_ & 3)) * DM); }
                                if (oo != 0xffffffffu) oo = (oo + cb + cl) * 4u;
#pragma unroll
                                for (int bj = 0; bj < 2; ++bj) {
                                    const f32x4 v0 = acc[ai][bj][m][0] * rs, v1 = acc[ai][bj][m][1] * rs;
                                    if (oo != 0xffffffffu) { *GP(f32x4, F.out, oo + 512 * bj) = v0; *GP(f32x4, F.out, oo + 512 * bj + 16) = v1; }
                                    *GP(u32x4, dst, lo2 + ai * AS2 + m * RS2 + 256 * bj) = pack8(v0, v1);
                                }
                                asm volatile("" ::: "memory");
                            }
                    } else if (slot == Z_Q) {
#pragma unroll
                        for (int ai = 0; ai < 2; ++ai)
#pragma unroll
                            for (int m = 0; m < 4; ++m) {
                                const float rs = rsv[ai][m] * 0.0625f;
#pragma unroll
                                for (int bj = 0; bj < 2; ++bj) *GP(u32x4, dst, lo2 + ai * AS2 + m * RS2 + 256 * bj) = pack8(acc[ai][bj][m][0] * rs, acc[ai][bj][m][1] * rs);
                                asm volatile("" ::: "memory");
                            }
                    } else {
#pragma unroll
                        for (int ai = 0; ai < 2; ++ai)
#pragma unroll
                            for (int m = 0; m < 4; ++m) {
                                const float rs = rsv[ai][m], nrs = -LOG2E * rs;
#pragma unroll
                                for (int bj = 0; bj < 2; ++bj) { f32x4 o[2];
#pragma unroll
                                    for (int n = 0; n < 2; ++n)
#pragma unroll
                                        for (int j = 0; j < 4; ++j) { const float a = acc[ai][bj][m][n][j]; o[n][j] = (a * rs) * __builtin_amdgcn_rcpf(1.0f + __builtin_amdgcn_exp2f(a * nrs)); }
                                    *GP(u32x4, dst, lo2 + ai * AS2 + m * RS2 + 256 * bj) = pack8(o[0], o[1]); }
                                asm volatile("" ::: "memory");
                            }
                    }
                }
            } else if (u.kind == K_KV) {
                const bool isK = u.pn < 4; const int cb = 256 * (u.pn & 3);
                char* od = (char*)(F.out + (isK ? O_MK : O_MV) + ((size_t)l * NBATCH + u.pm) * NMEM * DM + cb);
                char* kb = (char*)((bf16_t*)(F.ws + WS_KB) + ((size_t)u.pm * NHEAD + (u.pn & 3)) * NMEM * HDIM);
                const unsigned lok = (rl * 256u + cl) * 2u;
#pragma unroll
                for (int ai = 0; ai < 2; ++ai)
#pragma unroll
                    for (int m = 0; m < 4; ++m) {
#pragma unroll
                        for (int bj = 0; bj < 2; ++bj) {
                            *GP(f32x4, od, lo4 + ai * AS4 + m * RS4 + 512 * bj) = acc[ai][bj][m][0]; *GP(f32x4, od, lo4 + ai * AS4 + m * RS4 + 512 * bj + 16) = acc[ai][bj][m][1];
                            if (isK) *GP(u32x4, kb, lok + (128 * ai + 16 * m) * 512u + 256 * bj) = pack8(acc[ai][bj][m][0], acc[ai][bj][m][1]);
                        }
                        asm volatile("" ::: "memory");
                    }
            } else {
                char* dst = (char*)((bf16_t*)(F.ws + WS_VT) + ((size_t)u.pn * DM + 256 * u.pm) * 256);
                const unsigned lo = (rl * 256u + cl) * 2u;
#pragma unroll
                for (int ai = 0; ai < 2; ++ai)
#pragma unroll
                    for (int m = 0; m < 4; ++m) {
#pragma unroll
                        for (int bj = 0; bj < 2; ++bj) *GP(u32x4, dst, lo + (128 * ai + 16 * m) * 512u + 256 * bj) = pack8(acc[ai][bj][m][0], acc[ai][bj][m][1]);
                        asm volatile("" ::: "memory");
                    }
            }
        }
        if constexpr (PH == 3) { if (u.kind == K_S) {
            LAS f32x2* X = (LAS f32x2*)(lds + XTRA_OFF);
            float mw[2][4];
#pragma unroll
            for (int ai = 0; ai < 2; ++ai)
#pragma unroll
                for (int m = 0; m < 4; ++m) {
                    float mx = -3.0e38f;
#pragma unroll
                    for (int bj = 0; bj < 2; ++bj)
#pragma unroll
                        for (int n = 0; n < 2; ++n) { acc[ai][bj][m][n] = acc[ai][bj][m][n] * LOG2E; const f32x4 x = acc[ai][bj][m][n]; mx = fmaxf(mx, fmaxf(fmaxf(x[0], x[1]), fmaxf(x[2], x[3]))); }
                    mx = fmaxf(mx, __shfl_xor(mx, 16)); mx = fmaxf(mx, __shfl_xor(mx, 32));
                    float sm = 0.f;
#pragma unroll
                    for (int bj = 0; bj < 2; ++bj)
#pragma unroll
                        for (int n = 0; n < 2; ++n) { f32x4 x = acc[ai][bj][m][n];
#pragma unroll
                            for (int j = 0; j < 4; ++j) x[j] = __builtin_amdgcn_exp2f(x[j] - mx);
                            acc[ai][bj][m][n] = x; sm += (x[0] + x[1]) + (x[2] + x[3]); }
                    sm += __shfl_xor(sm, 16); sm += __shfl_xor(sm, 32);
                    mw[ai][m] = mx;
                    if (fq == 0) X[(rl + 128 * ai + 16 * m) * 4 + wc] = (f32x2){mx, sm};
                    asm volatile("" ::: "memory");
                }
            LDS_WAIT(); __builtin_amdgcn_s_barrier(); asm volatile("" ::: "memory");
            char* dst = (char*)((bf16_t*)(F.ws + WS_PS) + (size_t)u.pm * 256 * DM + 256 * u.pn);
#pragma unroll
            for (int ai = 0; ai < 2; ++ai)
#pragma unroll
                for (int m = 0; m < 4; ++m) {
                    const unsigned r = rl + 128 * ai + 16 * m;
                    const f32x2 p0 = X[r * 4 + 0], p1 = X[r * 4 + 1], p2 = X[r * 4 + 2], p3 = X[r * 4 + 3];
                    const float M = fmaxf(fmaxf(p0.x, p1.x), fmaxf(p2.x, p3.x));
                    const float Ls = p0.y * __builtin_amdgcn_exp2f(p0.x - M) + p1.y * __builtin_amdgcn_exp2f(p1.x - M) + p2.y * __builtin_amdgcn_exp2f(p2.x - M) + p3.y * __builtin_amdgcn_exp2f(p3.x - M);
                    const float f = __builtin_amdgcn_exp2f(mw[ai][m] - M) * __builtin_amdgcn_rcpf(Ls);
#pragma unroll
                    for (int bj = 0; bj < 2; ++bj) *GP(u32x4, dst, lo2 + ai * AS2 + m * RS2 + 256 * bj) = pack8(acc[ai][bj][m][0] * f, acc[ai][bj][m][1] * f);
                    asm volatile("" ::: "memory");
                }
            asm volatile("s_waitcnt vmcnt(0) lgkmcnt(0)" ::: "memory"); __builtin_amdgcn_s_barrier(); asm volatile("" ::: "memory");
        } else {
            const size_t tb = (size_t)u.pm * 256 * DM + 256 * u.pn;
            if (u.kind == K_O) {
                const char* g = (const char*)(F.z(Z_SGA) + tb); char* dst = (char*)((bf16_t*)(F.ws + WS_AATT) + tb);
                u32x4 gw[2][4][2];
#pragma unroll
                for (int ai = 0; ai < 2; ++ai)
#pragma unroll
                    for (int m = 0; m < 4; ++m)
#pragma unroll
                        for (int bj = 0; bj < 2; ++bj) gw[ai][m][bj] = *GPC(u32x4, g + (ai * AS2 + m * RS2), lo2 + 256 * bj);
#pragma unroll
                for (int ai = 0; ai < 2; ++ai) {
#pragma unroll
                    for (int m = 0; m < 4; ++m)
#pragma unroll
                        for (int bj = 0; bj < 2; ++bj) { f32x4 g0, g1; unpack8(gw[ai][m][bj], g0, g1);
                            wt_store16o(F.ws, (unsigned)(WS_AATT + tb * 2) + ai * AS2 + m * RS2, lo2 + 256 * bj, pack8(acc[ai][bj][m][0] * g0, acc[ai][bj][m][1] * g1)); }
                    asm volatile("" ::: "memory");
                }
            } else {
                const char* g = (const char*)(F.z(Z_SGP) + tb); char* dst = (char*)((bf16_t*)(F.ws + WS_APOOL) + tb);
                const char* ps = (const char*)(F.in[I_PSCALE] + (size_t)l * DM + 256 * u.pn);
                f32x4 sc[2][2];
#pragma unroll
                for (int bj = 0; bj < 2; ++bj) { sc[bj][0] = *GPC(f32x4, ps, (cl + 128 * bj) * 4u); sc[bj][1] = *GPC(f32x4, ps, (cl + 128 * bj) * 4u + 16); }
                u32x4 gw[2][4][2];
#pragma unroll
                for (int ai = 0; ai < 2; ++ai)
#pragma unroll
                    for (int m = 0; m < 4; ++m)
#pragma unroll
                        for (int bj = 0; bj < 2; ++bj) gw[ai][m][bj] = *GPC(u32x4, g + (ai * AS2 + m * RS2), lo2 + 256 * bj);
#pragma unroll
                for (int ai = 0; ai < 2; ++ai) {
#pragma unroll
                    for (int m = 0; m < 4; ++m)
#pragma unroll
                        for (int bj = 0; bj < 2; ++bj) { f32x4 g0, g1; unpack8(gw[ai][m][bj], g0, g1);
                            wt_store16o(F.ws, (unsigned)(WS_APOOL + tb * 2) + ai * AS2 + m * RS2, lo2 + 256 * bj, pack8(acc[ai][bj][m][0] * sc[bj][0] * g0, acc[ai][bj][m][1] * sc[bj][1] * g1)); }
                    asm volatile("" ::: "memory");
                }
            }
            asm volatile("s_waitcnt vmcnt(0)" ::: "memory");
            if (handoff) {
                __builtin_amdgcn_s_barrier();
                if (F.tid == 0) (void)xb_add((unsigned*)(F.ws + WS_CTL) + CW_P2 + 128 * l + u.pm, 1u);
            }
        } }
        if constexpr (PH == 4) {
            const size_t tb = (size_t)u.pm * 256 * DM + 256 * u.pn;
            const char* g = (const char*)(F.z(Z_SMC) + tb) + (size_t)u.aux * SLOT; char* dst = (char*)((bf16_t*)(F.ws + WS_MRG) + tb);
            u32x4 gw[2][4][2];
#pragma unroll
            for (int ai = 0; ai < 2; ++ai)
#pragma unroll
                for (int m = 0; m < 4; ++m)
#pragma unroll
                    for (int bj = 0; bj < 2; ++bj) gw[ai][m][bj] = *GPC(u32x4, g + (ai * AS2 + m * RS2), lo2 + 256 * bj);
            if (u.aux < 2) {
#pragma unroll
                for (int ai = 0; ai < 2; ++ai)
#pragma unroll
                    for (int m = 0; m < 4; ++m) {
#pragma unroll
                        for (int bj = 0; bj < 2; ++bj) { f32x4 g0, g1; u32x4 w = gw[ai][m][bj]; asm volatile("" : "+v"(w));
                            unpack8(w, g0, g1); acc[ai][bj][m][0] *= g0; acc[ai][bj][m][1] *= g1; }
                    }
            } else {
#pragma unroll
                for (int ai = 0; ai < 2; ++ai) {
#pragma unroll
                    for (int m = 0; m < 4; ++m)
#pragma unroll
                        for (int bj = 0; bj < 2; ++bj) { f32x4 g0, g1; unpack8(gw[ai][m][bj], g0, g1);
                            wt_store16o(F.ws, (unsigned)(WS_MRG + tb * 2) + ai * AS2 + m * RS2, lo2 + 256 * bj, pack8(acc[ai][bj][m][0] * g0, acc[ai][bj][m][1] * g1)); }
                    asm volatile("" ::: "memory");
                }
                asm volatile("s_waitcnt vmcnt(0)" ::: "memory");
                if (handoff) {
                    __builtin_amdgcn_s_barrier();
                    if (F.tid == 0) (void)xb_add((unsigned*)(F.ws + WS_CTL) + CW_MG + 128 * l + u.pm, 1u);
                }
            }
        }
        if constexpr (PH == 5) {
            const size_t tb = (size_t)u.pm * 256 * DM + 256 * u.pn;
            constexpr bool first = false; const bool last = (l + 1 == DEPTH);
            const char* xo = first ? (const char*)(((u.pm < 64) ? F.in[I_XP] : F.in[I_XS] - (size_t)MP * DM) + tb) : (const char*)((const bf16_t*)(F.ws + WS_XG) + tb);
            char* xn = (char*)(F.out + tb);
            char* xg = (char*)((bf16_t*)(F.ws + WS_XG) + tb);
            float* rss = F.rss(l + 1) + u.pm * 256;
            if (l + 1 == DEPTH && fuse_fn) {
#pragma unroll
                for (int ai = 0; ai < 2; ++ai) {
                    u32x4 xw[4][2];
#pragma unroll
                    for (int m = 0; m < 4; ++m)
#pragma unroll
                        for (int bj = 0; bj < 2; ++bj) xw[m][bj] = *GPC(u32x4, xo, lo2 + ai * AS2 + m * RS2 + 256 * bj);
#pragma unroll
                    for (int m = 0; m < 4; ++m) { float ss = 0.f;
#pragma unroll
                        for (int bj = 0; bj < 2; ++bj) { f32x4 x0, x1; unpack8(xw[m][bj], x0, x1);
                            const f32x4 v0 = x0 + acc[ai][bj][m][0], v1 = x1 + acc[ai][bj][m][1]; acc[ai][bj][m][0] = v0; acc[ai][bj][m][1] = v1;
                            ss += (v0[0] * v0[0] + v0[1] * v0[1]) + (v0[2] * v0[2] + v0[3] * v0[3]) + (v1[0] * v1[0] + v1[1] * v1[1]) + (v1[2] * v1[2] + v1[3] * v1[3]); }
                        ss += __shfl_xor(ss, 16); ss += __shfl_xor(ss, 32);
                        if (fq == 0 && rep == 0) __hip_atomic_fetch_add(GP(float, rss, (rl + 128 * ai + 16 * m) * 4u), ss, __ATOMIC_RELAXED, __HIP_MEMORY_SCOPE_AGENT); }
                    asm volatile("" ::: "memory");
                }
                asm volatile("s_waitcnt vmcnt(0)" ::: "memory"); __builtin_amdgcn_s_barrier();
                if (F.tid == 0) { unsigned* fc = (unsigned*)(F.ws + WS_CTL) + CW_FN + u.pm; if (rep == 0) (void)xb_add(fc, 1u); XB_SPIN(xb_ld(fc) < 4u, (unsigned*)(F.ws + WS_CTL) + CW_BAR); }
                __builtin_amdgcn_s_barrier();
                const char* gp = (const char*)(F.in[I_FNG] + 256 * u.pn);
                f32x4 gn[2][2];
#pragma unroll
                for (int bj = 0; bj < 2; ++bj) { gn[bj][0] = *GPC(f32x4, gp, (cl + 128 * bj) * 4u); gn[bj][1] = *GPC(f32x4, gp, (cl + 128 * bj) * 4u + 16); }
#pragma unroll
                for (int ai = 0; ai < 2; ++ai)
#pragma unroll
                    for (int m = 0; m < 4; ++m) {
                        const float rs = __hip_atomic_load(GP(float, rss, (rl + 128 * ai + 16 * m) * 4u), __ATOMIC_RELAXED, __HIP_MEMORY_SCOPE_AGENT);
                        const float rstd = rsqrtf(rs * (1.f / DM) + EPS);
#pragma unroll
                        for (int bj = 0; bj < 2; ++bj) { const unsigned o = lo4 + ai * AS4 + m * RS4 + 512 * bj;
                            *GP(f32x4, xn, o) = acc[ai][bj][m][0] * rstd * gn[bj][0]; *GP(f32x4, xn, o + 16) = acc[ai][bj][m][1] * rstd * gn[bj][1]; }
                        asm volatile("" ::: "memory");
                    }
                return;
            }
#define OUT_ROWS(ai, m, X0, X1) do { float ss = 0.f; \
                _Pragma("unroll") for (int bj = 0; bj < 2; ++bj) { const unsigned o = lo4 + (ai) * AS4 + (m) * RS4 + 512 * bj; \
                    const f32x4 v0 = X0[bj] + acc[ai][bj][m][0], v1 = X1[bj] + acc[ai][bj][m][1]; \
                    ss += (v0[0] * v0[0] + v0[1] * v0[1]) + (v0[2] * v0[2] + v0[3] * v0[3]) + (v1[0] * v1[0] + v1[1] * v1[1]) + (v1[2] * v1[2] + v1[3] * v1[3]); \
                    if (last) { *GP(f32x4, xn, o) = v0; *GP(f32x4, xn, o + 16) = v1; } \
                    else *GP(u32x4, xg, lo2 + (ai) * AS2 + (m) * RS2 + 256 * bj) = pack8(v0, v1); } \
                ss += __shfl_xor(ss, 16); ss += __shfl_xor(ss, 32); \
                if (fq == 0 && rep == 0) __hip_atomic_fetch_add(GP(float, rss, (rl + 128 * (ai) + 16 * (m)) * 4u), ss, __ATOMIC_RELAXED, __HIP_MEMORY_SCOPE_AGENT); } while (0)
            if (first) {
#pragma unroll
                for (int ai = 0; ai < 2; ++ai)
#pragma unroll
                  for (int mh = 0; mh < 2; ++mh) {
                    f32x4 xv[2][2][2];
#pragma unroll
                    for (int mm = 0; mm < 2; ++mm)
#pragma unroll
                        for (int bj = 0; bj < 2; ++bj) { const unsigned o = lo4 + ai * AS4 + (2 * mh + mm) * RS4 + 512 * bj; xv[mm][0][bj] = *GPC(f32x4, xo, o); xv[mm][1][bj] = *GPC(f32x4, xo, o + 16); }
#pragma unroll
                    for (int mm = 0; mm < 2; ++mm) OUT_ROWS(ai, 2 * mh + mm, xv[mm][0], xv[mm][1]);
                    asm volatile("" ::: "memory");
                  }
            } else {
#pragma unroll
                for (int ai = 0; ai < 2; ++ai) {
                    u32x4 xw[4][2];
#pragma unroll
                    for (int m = 0; m < 4; ++m)
#pragma unroll
                        for (int bj = 0; bj < 2; ++bj) xw[m][bj] = *GPC(u32x4, xo, lo2 + ai * AS2 + m * RS2 + 256 * bj);
#pragma unroll
                    for (int m = 0; m < 4; ++m) { f32x4 x0[2], x1[2];
#pragma unroll
                        for (int bj = 0; bj < 2; ++bj) unpack8(xw[m][bj], x0[bj], x1[bj]);
                        OUT_ROWS(ai, m, x0, x1); }
                    asm volatile("" ::: "memory");
                }
            }
#undef OUT_ROWS
        }
    }
};

__device__ __forceinline__ void satt_item(const Ctx& F0, int l, int b, int h) {
    Ctx F = F0; asm volatile("" : "+v"(F.tid)); F.lane = F.tid & 63;
    LAS float* S = (LAS float*)(F.lds + XTRA_OFF);
    LAS float* O = (LAS float*)(F.lds);
    const int lane = F.lane, w = F.wave;
    const size_t cbase = (((size_t)l * DBATCH + b) * NMEM + 32 * w) * DM + 256 * h + 4 * lane;
    const float* Kb = F.in[I_CK] + cbase; const float* Vb = F.in[I_CV] + cbase;
    f32x4 kv[32];
#pragma unroll
    for (int mi = 0; mi < 32; ++mi) kv[mi] = __builtin_nontemporal_load((const f32x4*)(Kb + (size_t)mi * DM));
    f32x4 q[4];
#pragma unroll
    for (int t = 0; t < 4; ++t) { const u32x2 v = *(const u32x2*)(F.z(Z_Q) + (size_t)(MP + 4 * b + t) * DM + 256 * h + 4 * lane); q[t] = (f32x4){bf_lo(v.x), bf_hi(v.x), bf_lo(v.y), bf_hi(v.y)}; }
    const bool hi5 = (lane & 32) != 0, hi4 = (lane & 16) != 0;
#pragma unroll
    for (int mi = 0; mi < 32; ++mi) {
        float d[4];
#pragma unroll
        for (int t = 0; t < 4; ++t) d[t] = (q[t][0] * kv[mi][0] + q[t][1] * kv[mi][1]) + (q[t][2] * kv[mi][2] + q[t][3] * kv[mi][3]);
        const float s0 = hi5 ? d[0] : d[2], k0 = hi5 ? d[2] : d[0], s1 = hi5 ? d[1] : d[3], k1 = hi5 ? d[3] : d[1];
        const float e0 = k0 + __shfl_xor(s0, 32), e1 = k1 + __shfl_xor(s1, 32);
        const float sx = hi4 ? e0 : e1, kx = hi4 ? e1 : e0;
        float f = kx + __shfl_xor(sx, 16);
        f += __builtin_bit_cast(float, __builtin_amdgcn_update_dpp(0, __builtin_bit_cast(int, f), 0xB1, 0xf, 0xf, false));
        f += __builtin_bit_cast(float, __builtin_amdgcn_update_dpp(0, __builtin_bit_cast(int, f), 0x4E, 0xf, 0xf, false));
        f += __builtin_bit_cast(float, __builtin_amdgcn_update_dpp(0, __builtin_bit_cast(int, f), 0x141, 0xf, 0xf, false));
        f += __builtin_bit_cast(float, __builtin_amdgcn_update_dpp(0, __builtin_bit_cast(int, f), 0x140, 0xf, 0xf, false));
        if ((lane & 15) == 0) S[(32 * w + mi) * 4 + (lane >> 4)] = f;
    }
    f32x4 vv[32];
#pragma unroll
    for (int mi = 0; mi < 32; ++mi) vv[mi] = __builtin_nontemporal_load((const f32x4*)(Vb + (size_t)mi * DM));
    __syncthreads();
    if (w < 4) {
        float s[4]; float mx = -3.0e38f;
#pragma unroll
        for (int i = 0; i < 4; ++i) { s[i] = S[(lane + 64 * i) * 4 + w] * LOG2E; mx = fmaxf(mx, s[i]); }
        mx = wave_max(mx); float sm = 0.f;
#pragma unroll
        for (int i = 0; i < 4; ++i) { s[i] = __builtin_amdgcn_exp2f(s[i] - mx); sm += s[i]; }
        sm = wave_sum(sm); const float inv = 1.0f / sm;
#pragma unroll
        for (int i = 0; i < 4; ++i) S[(lane + 64 * i) * 4 + w] = s[i] * inv;
    }
    __syncthreads();
    f32x4 o[4];
#pragma unroll
    for (int t = 0; t < 4; ++t) o[t] = (f32x4){0.f, 0.f, 0.f, 0.f};
#pragma unroll
    for (int mi = 0; mi < 32; ++mi) {
        const f32x4 p = *(const LAS f32x4*)(S + (32 * w + mi) * 4);
#pragma unroll
        for (int t = 0; t < 4; ++t) o[t] += vv[mi] * p[t];
    }
#pragma unroll
    for (int t = 0; t < 4; ++t) *(LAS f32x4*)(O + (w * 4 + t) * 256 + 4 * lane) = o[t];
    __syncthreads();
    if (F.tid < 128) {
        const int t = F.tid >> 5, c8 = (F.tid & 31) * 8;
        f32x4 a0 = (f32x4){0.f, 0.f, 0.f, 0.f}, a1 = a0;
#pragma unroll
        for (int ww = 0; ww < 8; ++ww) { a0 += *(const LAS f32x4*)(O + (ww * 4 + t) * 256 + c8); a1 += *(const LAS f32x4*)(O + (ww * 4 + t) * 256 + c8 + 4); }
        const size_t off = (size_t)(MP + 4 * b + t) * DM + 256 * h + c8;
        f32x4 g0, g1; unpack8(*(const u32x4*)(F.z(Z_SGA) + off), g0, g1);
        wt_store16(F.ws, (bf16_t*)(F.ws + WS_AATT) + off, pack8(a0 * g0, a1 * g1));
    }
    __syncthreads();
}

#define SATT_BASE(item) ((((size_t)l * DBATCH + ((item) >> 2)) * NMEM + 32 * w) * DM + 256 * ((item) & 3))
#define SATT_LOAD(buf, ptr) do { _Pragma("unroll") for (int mi = 0; mi < 16; ++mi) buf[mi] = __builtin_nontemporal_load((const f32x4*)((const char*)((ptr) + (size_t)mi * DM) + loff)); } while (0)
template <bool HAS_NEXT> __device__ __forceinline__ void satt_body(const Ctx& F, int l, int it, int nx, f32x4 (&A)[16], f32x4 (&B)[16], unsigned loff) {
    LAS float* S = (LAS float*)(F.lds + XTRA_OFF);
    LAS float* O = (LAS float*)(F.lds);
    const int lane = F.lane, w = F.wave;
    const bool hi5 = (lane & 32) != 0, hi4 = (lane & 16) != 0;
    const int b = it >> 2, h = it & 3;
    const size_t cb = SATT_BASE(it), cn = SATT_BASE(nx);
    f32x4 q[4];
#pragma unroll
    for (int t = 0; t < 4; ++t) { const u32x2 v = *(const u32x2*)(F.z(Z_Q) + (size_t)(MP + 4 * b + t) * DM + 256 * h + 4 * lane); q[t] = (f32x4){bf_lo(v.x), bf_hi(v.x), bf_lo(v.y), bf_hi(v.y)}; }
#define SATT_QK(buf, m0) do { _Pragma("unroll") for (int mi = 0; mi < 16; ++mi) { float d[4]; \
        _Pragma("unroll") for (int t = 0; t < 4; ++t) d[t] = (q[t][0] * buf[mi][0] + q[t][1] * buf[mi][1]) + (q[t][2] * buf[mi][2] + q[t][3] * buf[mi][3]); \
        const float s0 = hi5 ? d[0] : d[2], k0 = hi5 ? d[2] : d[0], s1 = hi5 ? d[1] : d[3], k1 = hi5 ? d[3] : d[1]; \
        const float e0 = k0 + __shfl_xor(s0, 32), e1 = k1 + __shfl_xor(s1, 32); \
        const float sx = hi4 ? e0 : e1, kx = hi4 ? e1 : e0; \
        float f = kx + __shfl_xor(sx, 16); \
        f += __builtin_bit_cast(float, __builtin_amdgcn_update_dpp(0, __builtin_bit_cast(int, f), 0xB1, 0xf, 0xf, false)); \
        f += __builtin_bit_cast(float, __builtin_amdgcn_update_dpp(0, __builtin_bit_cast(int, f), 0x4E, 0xf, 0xf, false)); \
        f += __builtin_bit_cast(float, __builtin_amdgcn_update_dpp(0, __builtin_bit_cast(int, f), 0x141, 0xf, 0xf, false)); \
        f += __builtin_bit_cast(float, __builtin_amdgcn_update_dpp(0, __builtin_bit_cast(int, f), 0x140, 0xf, 0xf, false)); \
        if ((lane & 15) == 0) S[(32 * w + (m0) + mi) * 4 + (lane >> 4)] = f; } } while (0)
#define SATT_PV(buf, m0) do { _Pragma("unroll") for (int mi = 0; mi < 16; ++mi) { const f32x4 p = *(const LAS f32x4*)(S + (32 * w + (m0) + mi) * 4); \
        _Pragma("unroll") for (int t = 0; t < 4; ++t) o[t] += buf[mi] * p[t]; } } while (0)
    __builtin_amdgcn_sched_barrier(0);
    SATT_QK(A, 0);
    __builtin_amdgcn_sched_barrier(0);
    SATT_LOAD(A, F.in[I_CV] + cb);
    __builtin_amdgcn_sched_barrier(0);
    SATT_QK(B, 16);
    __builtin_amdgcn_sched_barrier(0);
    SATT_LOAD(B, F.in[I_CV] + cb + (size_t)16 * DM);
    __builtin_amdgcn_sched_barrier(0);
    __syncthreads();
    if (w < 4) {
        float s[4]; float mx = -3.0e38f;
#pragma unroll
        for (int i = 0; i < 4; ++i) { s[i] = S[(lane + 64 * i) * 4 + w] * LOG2E; mx = fmaxf(mx, s[i]); }
        mx = wave_max(mx); float sm = 0.f;
#pragma unroll
        for (int i = 0; i < 4; ++i) { s[i] = __builtin_amdgcn_exp2f(s[i] - mx); sm += s[i]; }
        sm = wave_sum(sm); const float inv = 1.0f / sm;
#pragma unroll
        for (int i = 0; i < 4; ++i) S[(lane + 64 * i) * 4 + w] = s[i] * inv;
    }
    __syncthreads();
    f32x4 o[4];
#pragma unroll
    for (int t = 0; t < 4; ++t) o[t] = (f32x4){0.f, 0.f, 0.f, 0.f};
    SATT_PV(A, 0);
    __builtin_amdgcn_sched_barrier(0);
    if constexpr (HAS_NEXT) SATT_LOAD(A, F.in[I_CK] + cn);
    __builtin_amdgcn_sched_barrier(0);
    SATT_PV(B, 16);
    __builtin_amdgcn_sched_barrier(0);
    if constexpr (HAS_NEXT) SATT_LOAD(B, F.in[I_CK] + cn + (size_t)16 * DM);
    __builtin_amdgcn_sched_barrier(0);
#pragma unroll
    for (int t = 0; t < 4; ++t) *(LAS f32x4*)(O + (w * 4 + t) * 256 + 4 * lane) = o[t];
    __syncthreads();
    if (F.tid < 128) {
        const int t = F.tid >> 5, c8 = (F.tid & 31) * 8;
        f32x4 a0 = (f32x4){0.f, 0.f, 0.f, 0.f}, a1 = a0;
#pragma unroll
        for (int ww = 0; ww < 8; ++ww) { a0 += *(const LAS f32x4*)(O + (ww * 4 + t) * 256 + c8); a1 += *(const LAS f32x4*)(O + (ww * 4 + t) * 256 + c8 + 4); }
        const size_t off = (size_t)(MP + 4 * b + t) * DM + 256 * h + c8;
        f32x4 g0, g1; unpack8(*(const u32x4*)(F.z(Z_SGA) + off), g0, g1);
        wt_store16(F.ws, (bf16_t*)(F.ws + WS_AATT) + off, pack8(a0 * g0, a1 * g1));
    }
    __syncthreads();
#undef SATT_QK
#undef SATT_PV
}
__device__ __forceinline__ void satt_pair(const Ctx& F0, int l, int it0, int it1) {
    Ctx F = F0; asm volatile("" : "+v"(F.tid)); F.lane = F.tid & 63;
    const int w = F.wave;
    unsigned loff = (unsigned)F.lane * 16u; asm volatile("" : "+v"(loff));
    f32x4 A[16], B[16];
    { const size_t cb = SATT_BASE(it0); SATT_LOAD(A, F.in[I_CK] + cb); SATT_LOAD(B, F.in[I_CK] + cb + (size_t)16 * DM); }
    satt_body<true>(F, l, it0, it1, A, B, loff);
    satt_body<false>(F, l, it1, it1, A, B, loff);
}
#undef SATT_BASE
#undef SATT_LOAD
__device__ __forceinline__ void satt_stream(const Ctx& F, int l) {
    int it = F.c;
#pragma nounroll
    for (; it + F.G < 512; it += 2 * F.G) satt_pair(F, l, it, it + F.G);
    if (it < 512) satt_item(F, l, it >> 2, it & 3);
}

__device__ __forceinline__ void st16_wt_ws(unsigned char* ws, const void* p, u32x4 v) {
    const __amdgpu_buffer_rsrc_t r = __builtin_amdgcn_make_buffer_rsrc(ws, 0, 0x7fffffff, 0x00027000);
    __builtin_amdgcn_raw_buffer_store_b128(v, r, (int)(unsigned)((const unsigned char*)p - ws), 0, 16);
}
struct V8 { f32x4 a, b; };
__device__ __forceinline__ V8 v8_zero() { V8 r; r.a = (f32x4){0.f, 0.f, 0.f, 0.f}; r.b = r.a; return r; }
__device__ __forceinline__ V8 ld_bf8(const bf16_t* p) { V8 r; unpack8(*(const u32x4*)p, r.a, r.b); return r; }
__device__ __forceinline__ V8 ld_f8(const float* p) { V8 r; r.a = *(const f32x4*)p; r.b = *(const f32x4*)(p + 4); return r; }
template <int W, bool PROMPT> __device__ __forceinline__ void cm_task(const Ctx& F, int l, int rq, int c0) {
    const bf16_t* U = F.z(Z_U) + c0; const bf16_t* BS = F.z(Z_BS) + c0; const bf16_t* HP = F.z(Z_HP) + c0;
    bf16_t* AC = (bf16_t*)(F.ws + WS_ACONV) + c0; bf16_t* MX = (bf16_t*)(F.ws + WS_MIX) + c0;
    const int r0 = 4 * rq, t0 = r0 & (SEQ - 1), b = rq - MP / 4;
    const f32x4 z4 = (f32x4){0.f, 0.f, 0.f, 0.f};
    u32x4 uw[6], bw[4], xw[W + 3];
    V8 us[2];
    const float* sp = F.in[I_SPOOL] + ((size_t)l * DBATCH + b) * 15 * DM + c0;
    if constexpr (PROMPT) {
#pragma unroll
        for (int j = 0; j < 6; ++j) { const int row = (j >= 2 || t0 != 0) ? r0 - 2 + j : r0; uw[j] = *(const u32x4*)(U + (size_t)row * DM); }
#pragma unroll
        for (int j = 0; j < W + 3; ++j) { const int row = (t0 - (W - 1) + j >= 0) ? r0 - (W - 1) + j : r0; xw[j] = *(const u32x4*)(HP + (size_t)row * DM); }
    } else {
        const float* sc = F.in[I_SCONV] + ((size_t)l * DBATCH + b) * 2 * DM + c0;
#pragma unroll
        for (int j = 0; j < 2; ++j) us[j] = ld_f8(sc + j * DM);
#pragma unroll
        for (int j = 2; j < 6; ++j) uw[j] = *(const u32x4*)(U + (size_t)(r0 - 2 + j) * DM);
#pragma unroll
        for (int j = 0; j < W + 3; ++j) { constexpr int dummy = 0; (void)dummy; const int e = 16 - W + j;
            if (e >= 15) xw[j] = *(const u32x4*)(HP + (size_t)(r0 + e - 15) * DM); }
    }
    V8 tpre[8];
    if constexpr (!PROMPT) {
#pragma unroll
        for (int i = 0; i < 8; ++i) if (i < W - 1) tpre[i] = ld_f8(sp + (size_t)(16 - W + i) * DM);
    }
#pragma unroll
    for (int k = 0; k < 4; ++k) bw[k] = *(const u32x4*)(BS + (size_t)(r0 + k) * DM);
    const float* cw = F.in[I_CONVW] + (size_t)l * 3 * DM + c0;
    const V8 w0 = ld_f8(cw), w1 = ld_f8(cw + DM), w2 = ld_f8(cw + 2 * DM);
    {
        V8 u[6];
#pragma unroll
        for (int j = 0; j < 6; ++j) {
            if (PROMPT || j >= 2) { unpack8(uw[j], u[j].a, u[j].b); if (PROMPT && j < 2 && t0 == 0) { u[j].a = z4; u[j].b = z4; } }
            else u[j] = us[j];
        }
#pragma unroll
        for (int k = 0; k < 4; ++k) {
            V8 bs; unpack8(bw[k], bs.a, bs.b);
            const f32x4 y0 = w0.a * u[k].a + w1.a * u[k + 1].a + w2.a * u[k + 2].a, y1 = w0.b * u[k].b + w1.b * u[k + 1].b + w2.b * u[k + 2].b;
            st16_wt_ws(F.ws, AC + (size_t)(r0 + k) * DM, pack8(bs.a * y0, bs.b * y1));
        }
    }
    {
        auto gettok = [&](int j) -> V8 { V8 v; unpack8(xw[j], v.a, v.b); return v; };
        V8 s = v8_zero(), x0 = s, x1 = s, x2 = s;
        if constexpr (PROMPT) {
#pragma unroll
            for (int j = 0; j < W; ++j) { V8 v = gettok(j); if (j < W - 1 && t0 - (W - 1) + j < 0) { v.a = z4; v.b = z4; }
                s.a += v.a; s.b += v.b; if (j == 0) x0 = v; if (j == 1) x1 = v; if (j == 2) x2 = v; }
            if (W == 2) x2 = gettok(2);
        } else {
            constexpr int NS = W - 1;
#pragma unroll
            for (int j0 = 0; j0 < NS; j0 += 8) {
                V8 t[8];
#pragma unroll
                for (int i = 0; i < 8; ++i) if (j0 + i < NS) { if (j0 == 0) t[i] = tpre[i]; else t[i] = ld_f8(sp + (size_t)(16 - W + j0 + i) * DM); }
#pragma unroll
                for (int i = 0; i < 8; ++i) if (j0 + i < NS) { const int j = j0 + i; s.a += t[i].a; s.b += t[i].b; if (j == 0) x0 = t[i]; if (j == 1) x1 = t[i]; if (j == 2) x2 = t[i]; }
            }
            { const V8 v = gettok(W - 1); s.a += v.a; s.b += v.b; if (W - 1 == 1) x1 = v; if (W - 1 == 2) x2 = v; }
            if (W == 2) x2 = gettok(2);
        }
#pragma unroll
        for (int k = 0; k < 4; ++k) {
            const V8 tk = gettok(W - 1 + k);
            const int cnt = PROMPT ? ((t0 + k + 1 < W) ? (t0 + k + 1) : W) : W;
            const float inv = 1.0f / (float)cnt;
            if constexpr (PROMPT) *(u32x4*)(MX + (size_t)(r0 + k) * DM) = pack8(s.a * inv - tk.a, s.b * inv - tk.b);
            else st16_wt_ws(F.ws, MX + (size_t)(r0 + k) * DM, pack8(s.a * inv - tk.a, s.b * inv - tk.b));
            if (k < 3) { const V8 xo = (k == 0) ? x0 : (k == 1 ? x1 : x2), xn = gettok(W + k); s.a += xn.a - xo.a; s.b += xn.b - xo.b; }
        }
    }
}

template <int K> __device__ __forceinline__ f32x4 small_tile(const Ctx& F, const bf16_t* A, int lda, const bf16_t* Bt, int ldb, int lane) {
    constexpr int KS = K / 8 / 32;
    const int fr = lane & 15, fq = lane >> 4, w = F.wave;
    const bf16_t* ap = A + (size_t)fr * lda + w * (K / 8) + 8 * fq;
    const bf16_t* bp = Bt + (size_t)fr * ldb + w * (K / 8) + 8 * fq;
    bf16x8 a[4][KS], b[2][KS];
#pragma unroll
    for (int ks = 0; ks < KS; ++ks) {
#pragma unroll
        for (int cg = 0; cg < 2; ++cg) b[cg][ks] = *(const bf16x8*)(bp + (size_t)(16 * cg) * ldb + 32 * ks);
#pragma unroll
        for (int rg = 0; rg < 4; ++rg) a[rg][ks] = *(const bf16x8*)(ap + (size_t)(16 * rg) * lda + 32 * ks);
    }
    __builtin_amdgcn_sched_barrier(0);
    LAS f32x4* P = (LAS f32x4*)F.lds;
#pragma unroll
    for (int rg = 0; rg < 4; ++rg)
#pragma unroll
        for (int cg = 0; cg < 2; ++cg) {
            f32x4 acc = (f32x4){0.f, 0.f, 0.f, 0.f};
#pragma unroll
            for (int ks = 0; ks < KS; ++ks) acc = __builtin_amdgcn_mfma_f32_16x16x32_bf16(b[cg][ks], a[rg][ks], acc, 0, 0, 0);
            P[(w * 8 + rg * 2 + cg) * 64 + lane] = acc;
        }
    __syncthreads();
    f32x4 s = P[(0 * 8 + w) * 64 + lane];
#pragma unroll
    for (int ww = 1; ww < 8; ++ww) s += P[(ww * 8 + w) * 64 + lane];
    __syncthreads();
    return s;
}
__device__ __forceinline__ f32x4 ld_bf4(const bf16_t* p) { const u32x2 v = *(const u32x2*)p; return (f32x4){bf_lo(v.x), bf_hi(v.x), bf_lo(v.y), bf_hi(v.y)}; }
__device__ __forceinline__ void st_bf4(bf16_t* p, f32x4 v) { u32x2 w; w.x = cvt_pk_bf16(v[0], v[1]); w.y = cvt_pk_bf16(v[2], v[3]); *(u32x2*)p = w; }
#define SMALL_IDS() int lane = F.lane; asm volatile("" : "+v"(lane)); const int fr = lane & 15, fq = lane >> 4; \
    const int r0 = MP + 64 * (t >> 5), n0 = 32 * (t & 31), row = r0 + 16 * (F.wave >> 1) + fr, col = n0 + 16 * (F.wave & 1) + 4 * fq; \
    const size_t off = (size_t)row * DM + col
__device__ __forceinline__ void small_pool(const Ctx& F, int l) {
    for (int t = F.c; t < 256; t += F.G) { SMALL_IDS();
        const int g = n0 >> 8;
        const f32x4 ps = *(const f32x4*)(F.in[I_PSCALE] + (size_t)l * DM + col), sg = ld_bf4(F.z(Z_SGP) + off);
        const f32x4 acc = small_tile<256>(F, (const bf16_t*)(F.ws + WS_MIX) + (size_t)r0 * DM + 256 * g, DM, (const bf16_t*)(F.ws + WS_PW) + (((size_t)l * 4 + g) * 256 + (n0 & 255)) * 256, 256, lane);
        { const f32x4 o4 = acc * ps * sg; u32x2 w2; w2.x = cvt_pk_bf16(o4[0], o4[1]); w2.y = cvt_pk_bf16(o4[2], o4[3]); wt_store8(F.ws, (bf16_t*)(F.ws + WS_APOOL) + off, w2); }
    }
}
constexpr int SS_PITCH = 144, SS_SLAB = 96 * SS_PITCH;
constexpr int SS_GATE_OFF = 8 * SS_SLAB;
static_assert(SS_GATE_OFF + 3 * 64 * 64 <= XTRA_OFF, "small-tile LDS map");
struct SmallStage { u32x4 a[8], b[4]; };
__device__ __forceinline__ void small_stage_load(SmallStage& s, const bf16_t* ap, const bf16_t* bp) {
#pragma unroll
    for (int q = 0; q < 8; ++q) s.a[q] = *(const u32x4*)(ap + (size_t)(8 * q) * DM);
#pragma unroll
    for (int q = 0; q < 4; ++q) s.b[q] = *(const u32x4*)(bp + (size_t)(8 * q) * DM);
}
__device__ __forceinline__ void small_stage_mma(const SmallStage& s, LAS unsigned char* wl, unsigned wo, unsigned ro, f32x4 (&tot)[4][2]) {
#pragma unroll
    for (int q = 0; q < 8; ++q) *(LAS u32x4*)(wl + wo + q * (8 * SS_PITCH)) = s.a[q];
#pragma unroll
    for (int q = 0; q < 4; ++q) *(LAS u32x4*)(wl + wo + (64 + 8 * q) * SS_PITCH) = s.b[q];
    bf16x8 a[4][2], b[2][2];
#pragma unroll
    for (int ks = 0; ks < 2; ++ks) {
#pragma unroll
        for (int cg = 0; cg < 2; ++cg) b[cg][ks] = *(const LAS bf16x8*)(wl + ro + (64 + 16 * cg) * SS_PITCH + 64 * ks);
#pragma unroll
        for (int rg = 0; rg < 4; ++rg) a[rg][ks] = *(const LAS bf16x8*)(wl + ro + (16 * rg) * SS_PITCH + 64 * ks);
    }
#pragma unroll
    for (int rg = 0; rg < 4; ++rg)
#pragma unroll
        for (int cg = 0; cg < 2; ++cg)
#pragma unroll
            for (int ks = 0; ks < 2; ++ks) tot[rg][cg] = __builtin_amdgcn_mfma_f32_16x16x32_bf16(b[cg][ks], a[rg][ks], tot[rg][cg], 0, 0, 0);
}
__device__ __forceinline__ f32x4 small_reduce(const Ctx& F, const f32x4 (&tot)[4][2], int lane) {
    LAS f32x4* P = (LAS f32x4*)F.lds;
    const int w = F.wave;
    __syncthreads();
#pragma unroll
    for (int rg = 0; rg < 4; ++rg)
#pragma unroll
        for (int cg = 0; cg < 2; ++cg) P[(w * 8 + rg * 2 + cg) * 64 + lane] = tot[rg][cg];
    __syncthreads();
    f32x4 s = P[(0 * 8 + w) * 64 + lane];
#pragma unroll
    for (int ww = 1; ww < 8; ++ww) s += P[(ww * 8 + w) * 64 + lane];
    __syncthreads();
    return s;
}
#define SMALL_STAGE_IDS() const int w = F.wave; LAS unsigned char* wl = F.lds + w * SS_SLAB; \
    const unsigned wo = (unsigned)((lane >> 3) * SS_PITCH + (lane & 7) * 16), ro = (unsigned)(fr * SS_PITCH + fq * 16); \
    const size_t lrow = (size_t)(lane >> 3) * DM + w * 128 + 8 * (lane & 7)
__device__ __forceinline__ void small_branches(const Ctx& F, int l, bool handoff) {
    for (int t = F.c; t < 256; t += F.G) { SMALL_IDS(); SMALL_STAGE_IDS();
        const bf16_t* ap = (const bf16_t*)(F.ws + WS_ACONV) + (size_t)r0 * DM + lrow;
        const bf16_t* bp = (const bf16_t*)(F.ws + WS_WBR) + (((size_t)l * 3) * DM + n0) * DM + lrow;
#define SB_A(s) ((const bf16_t*)((const char*)ap + (size_t)((s) >> 1) * SLOT) + 64 * ((s) & 1))
#define SB_B(s) (bp + (size_t)((s) >> 1) * DM * DM + 64 * ((s) & 1))
        u32x4 gv[2];
        int tid_ = F.tid; asm volatile("" : "+v"(tid_));
#pragma unroll
        for (int i = 0; i < 2; ++i) { const int p = tid_ + 512 * i; if (p < 768) gv[i] = *(const u32x4*)((const char*)(F.z(Z_SMC) + (size_t)(r0 + ((p & 255) >> 2)) * DM + n0 + 8 * (p & 3)) + (size_t)(p >> 8) * SLOT); }
        SmallStage st[3];
        f32x4 tot[4][2];
#pragma unroll
        for (int rg = 0; rg < 4; ++rg)
#pragma unroll
            for (int cg = 0; cg < 2; ++cg) tot[rg][cg] = (f32x4){0.f, 0.f, 0.f, 0.f};
        small_stage_load(st[0], SB_A(0), SB_B(0)); small_stage_load(st[1], SB_A(1), SB_B(1));
        __builtin_amdgcn_sched_barrier(0);
#pragma unroll
        for (int i = 0; i < 2; ++i) { const int p = tid_ + 512 * i; if (p < 768) *(LAS u32x4*)(F.lds + SS_GATE_OFF + 16 * p) = gv[i]; }
#pragma unroll
        for (int s = 0; s < 6; ++s) {
            if (s + 2 < 6) small_stage_load(st[(s + 2) % 3], SB_A(s + 2), SB_B(s + 2));
            __builtin_amdgcn_sched_barrier(0);
            small_stage_mma(st[s % 3], wl, wo, ro, tot);
            if (s & 1) {
                if (s == 1) __syncthreads();
                const LAS unsigned char* gl = F.lds + SS_GATE_OFF + (s >> 1) * 4096 + fr * 64 + fq * 8;
#pragma unroll
                for (int rg = 0; rg < 4; ++rg)
#pragma unroll
                    for (int cg = 0; cg < 2; ++cg) { const u32x2 g = *(const LAS u32x2*)(gl + rg * 1024 + cg * 32); tot[rg][cg] = tot[rg][cg] * (f32x4){bf_lo(g.x), bf_hi(g.x), bf_lo(g.y), bf_hi(g.y)}; }
            }
            __builtin_amdgcn_sched_barrier(0);
        }
#undef SB_A
#undef SB_B
        const f32x4 s4 = small_reduce(F, tot, lane);
        if (!handoff) st_bf4((bf16_t*)(F.ws + WS_MRG) + off, s4);
        else { u32x2 w2; w2.x = cvt_pk_bf16(s4[0], s4[1]); w2.y = cvt_pk_bf16(s4[2], s4[3]); wt_store8(F.ws, (bf16_t*)(F.ws + WS_MRG) + off, w2);
            asm volatile("s_waitcnt vmcnt(0)" ::: "memory"); __syncthreads();
            if (F.tid == 0) (void)xb_add((unsigned*)(F.ws + WS_CTL) + CW_MG + 128 * l + 66 + (t >> 5), 1u); }
    }
}
__device__ __forceinline__ void small_out(const Ctx& F, int l, bool fuse_fn, bool handoff) {
    for (int t = F.c; t < 256; t += F.G) { SMALL_IDS(); SMALL_STAGE_IDS();
        if (handoff) {
            if (F.tid == 0) { unsigned* mc = (unsigned*)(F.ws + WS_CTL) + CW_MG + 128 * l + 66 + (t >> 5); XB_SPIN(xb_ld(mc) < 32u, (unsigned*)(F.ws + WS_CTL) + CW_BAR); __builtin_amdgcn_fence(__ATOMIC_ACQUIRE, "agent"); }
            __syncthreads();
        }
        f32x4 xold;
        xold = ld_bf4((const bf16_t*)(F.ws + WS_XG) + off);
        const bf16_t* ap = (const bf16_t*)(F.ws + WS_MRG) + (size_t)r0 * DM + lrow;
        const bf16_t* bp = (const bf16_t*)(F.ws + WS_WO) + ((size_t)l * DM + n0) * DM + lrow;
        SmallStage st[2];
        f32x4 tot[4][2];
#pragma unroll
        for (int rg = 0; rg < 4; ++rg)
#pragma unroll
            for (int cg = 0; cg < 2; ++cg) tot[rg][cg] = (f32x4){0.f, 0.f, 0.f, 0.f};
        small_stage_load(st[0], ap, bp); small_stage_load(st[1], ap + 64, bp + 64);
        __builtin_amdgcn_sched_barrier(0);
        small_stage_mma(st[0], wl, wo, ro, tot);
        __builtin_amdgcn_sched_barrier(0);
        small_stage_mma(st[1], wl, wo, ro, tot);
        const f32x4 acc = small_reduce(F, tot, lane);
        const f32x4 v = xold + acc;
        float ss = (v[0] * v[0] + v[1] * v[1]) + (v[2] * v[2] + v[3] * v[3]);
        ss += __shfl_xor(ss, 16); ss += __shfl_xor(ss, 32);
        if (fq == 0) __hip_atomic_fetch_add(F.rss(l + 1) + row, ss, __ATOMIC_RELAXED, __HIP_MEMORY_SCOPE_AGENT);
        if (l + 1 < DEPTH) st_bf4((bf16_t*)(F.ws + WS_XG) + off, v);
        else if (!fuse_fn) *(f32x4*)(F.out + off) = v;
        else {
            asm volatile("s_waitcnt vmcnt(0)" ::: "memory"); __syncthreads();
            if (F.tid == 0) { unsigned* fc = (unsigned*)(F.ws + WS_CTL) + CW_FN + 66 + (t >> 5); (void)xb_add(fc, 1u); XB_SPIN(xb_ld(fc) < 32u, (unsigned*)(F.ws + WS_CTL) + CW_BAR); }
            __syncthreads();
            const float rs = __hip_atomic_load(F.rss(l + 1) + row, __ATOMIC_RELAXED, __HIP_MEMORY_SCOPE_AGENT);
            *(f32x4*)(F.out + off) = v * rsqrtf(rs * (1.f / DM) + EPS) * *(const f32x4*)(F.in[I_FNG] + col);
        }
    }
}

__global__ void __launch_bounds__(NWAVES * 64, 2) fwd_megakernel(Args args) {
    extern __shared__ __attribute__((aligned(16))) unsigned char lds_raw[];
    Ctx F;
#pragma unroll
    for (int i = 0; i < 19; ++i) F.in[i] = args.in[i];
    F.out = args.out; F.ws = args.ws;
    F.lds = (LAS unsigned char*)lds_raw;
    F.tid = threadIdx.x; F.lane = F.tid & 63; F.wave = __builtin_amdgcn_readfirstlane(F.tid >> 6);
    F.G = gridDim.x; F.c = blockIdx.x; F.vcu = (F.G % 8 == 0) ? (F.c % 8) * (F.G / 8) + F.c / 8 : F.c;
    volatile LAS unsigned* MISC = (volatile LAS unsigned*)(F.lds + MISC_OFF);
    if (F.tid < 32) MISC[F.tid] = 0u;
    __syncthreads();
    unsigned* ctl = (unsigned*)(F.ws + WS_CTL);
    XcdBarrier bar = xcd_barrier_post(ctl + CW_BAR, MISC + 8);
#define GRID_BAR() xcd_barrier(bar)

    for (int rep = 0; rep < (REP_PH == 6 ? 2 : 1); ++rep) {
    p0_prologue(F);
    GRID_BAR();
    }
    const char* ws = (const char*)F.ws;
#pragma nounroll
    for (int l = 0; l < DEPTH; ++l) {
        for (int rep = 0; rep < (REP_PH == 1 ? 2 : 1); ++rep) {
            SchedP1 S{F.G, F.c, ws + WS_XG, ws + WS_WIN + (size_t)l * DIN * DM * 2, ws + WS_HM + (size_t)l * NBATCH * NMEM * DM * 2, ws + WS_WKV + (size_t)l * 2048 * DM * 2};
            Epi<1> E{F, l};
            pg8::gemm_phase(F.lds, DM, DM, DM, S, E);
            if (l + 1 < DEPTH && rep == 0) {
                const int nfull = 3000 % F.G, j = F.c - nfull;
                if (j >= 0) convert_weights(F, (l + 1) * XI_PER_LAYER, (l + 1) * XI_PER_LAYER + XI_LATE, j * NWAVES + F.wave, (F.G - nfull) * NWAVES);
            }
            if (l >= 1 && rep == 0) { const int nfull = 3000 % F.G, j = F.c - nfull; if (j >= 0) convert_weights(F, l * XI_PER_LAYER + XI_OWN, (l + 1) * XI_PER_LAYER, j * NWAVES + F.wave, (F.G - nfull) * NWAVES); }
            if (l + 1 == DEPTH && rep == 0) { const int nfull = 3000 % F.G, j = F.c - nfull; if (j >= 0) pool_state_copy(F, j, F.G - nfull); }
        GRID_BAR();
        }
        for (int rep = 0; rep < (REP_PH == 2 ? 2 : 1); ++rep) {
            const bool p2_handoff = (F.G == 256) && (REP_PH == 0);
            const int att_pos = (F.c >> 3) % 3;
#pragma nounroll
            for (int pos = 0; pos < 3; ++pos) {
            if (att_pos == pos) satt_stream(F, l);
            if (pos == 0) { {
                int lane = F.lane; asm volatile("" : "+v"(lane));
                const int cvl = lane & 31, rqi = lane >> 5;
                for (int pg = F.c; pg < 256; pg += F.G) {
                    const int pm = pg >> 2, g = pg & 3, c0 = 256 * g + 8 * cvl;
                    for (int k = 0; k < 4; ++k) { const int rq = 2 * (32 * pm + F.wave + 8 * k) + rqi;
                        if (g == 0) cm_task<2, true>(F, l, rq, c0); else if (g == 1) cm_task<4, true>(F, l, rq, c0); else if (g == 2) cm_task<8, true>(F, l, rq, c0); else cm_task<16, true>(F, l, rq, c0); }
                }
                if (F.wave == 0) for (int t = F.c; t < 256; t += F.G) {
                    const int g = (t & 31) >> 3, c0 = 256 * g + 8 * cvl, rq = 2 * (MP / 8 + 8 * (t >> 5) + (t & 7)) + rqi;
                    if (g == 0) cm_task<2, false>(F, l, rq, c0); else if (g == 1) cm_task<4, false>(F, l, rq, c0); else if (g == 2) cm_task<8, false>(F, l, rq, c0); else cm_task<16, false>(F, l, rq, c0);
                }
            }
            asm volatile("s_waitcnt vmcnt(0)" ::: "memory"); __syncthreads();
            if (F.tid == 0 && rep == 0) for (int t = F.c; t < 256; t += F.G) (void)xb_add(ctl + CW_SP + 64 * l + (t >> 3), 1u);
            if (F.tid == 0 && rep == 0) for (int pg = F.c; pg < 256; pg += F.G) (void)xb_add(ctl + CW_P2 + 128 * l + (pg >> 2), 1u);
            }
            if (pos == 1) { {
                SchedP2 S{F.G, F.c, (const char*)F.z(Z_Q), ws + WS_KB, ws + WS_PS, ws + WS_VT, ws + WS_MIX, ws + WS_PW + (size_t)l * 4 * 256 * 256 * 2};
                Epi<3> E{F, l, 0, false, p2_handoff};
                pg8::gemm_phase(F.lds, 256, DM, 256, S, E);
            }
            if (F.tid == 0) { for (int t = F.c; t < 256; t += F.G) { unsigned* sp = ctl + CW_SP + 64 * l + (t >> 3); XB_SPIN(xb_ld(sp) < 8u, ctl + CW_BAR); }
                __builtin_amdgcn_fence(__ATOMIC_ACQUIRE, "agent"); }
            __syncthreads();
            small_pool(F, l);
            }
            }
            if (p2_handoff) {
                asm volatile("s_waitcnt vmcnt(0)" ::: "memory"); __syncthreads();
                if (F.tid == 0) (void)xb_add(ctl + CW_P2 + 128 * l + 100, 1u);
            } else
        GRID_BAR();
        }
        for (int rep = 0; rep < (REP_PH == 4 ? 2 : 1); ++rep) {
            SchedP3 S{F.G, F.c, ws + WS_ACONV, ws + WS_WBR + (size_t)l * 3 * DM * DM * 2};
            const bool handoff = (F.G == 256) && (REP_PH == 0);
            Epi<4> E{F, l, 0, false, handoff};
            if (handoff) {
                if (F.tid == 0) { int pm, pn; pg8::tile_remap(F.c, 64, 4, pm, pn); unsigned* pc = ctl + CW_P2 + 128 * l + pm; XB_SPIN(xb_ld(pc) < 12u, ctl + CW_BAR); __builtin_amdgcn_fence(__ATOMIC_ACQUIRE, "agent"); }
                __syncthreads();
            }
            pg8::gemm_phase(F.lds, DM, DM, DM, S, E);
            if (handoff) {
                if (F.tid == 0) { unsigned* pc = ctl + CW_P2 + 128 * l + 100; XB_SPIN(xb_ld(pc) < (unsigned)F.G, ctl + CW_BAR); __builtin_amdgcn_fence(__ATOMIC_ACQUIRE, "agent"); }
                __syncthreads();
            }
            small_branches(F, l, handoff);
            if (!handoff)
        GRID_BAR();
        }
        for (int rep = 0; rep < (REP_PH == 5 ? 2 : 1); ++rep) {
            SchedP4 S{F.G, F.c, ws + WS_MRG, ws + WS_WO + (size_t)l * DM * DM * 2};
            const bool fuse_fn = (F.G == 256) && (REP_PH == 0);
            Epi<5> E{F, l, rep, fuse_fn};
            if (fuse_fn) {
                if (F.tid == 0) { int pm, pn; pg8::tile_remap(F.c, 64, 4, pm, pn); unsigned* mc = ctl + CW_MG + 128 * l + pm; XB_SPIN(xb_ld(mc) < 4u, ctl + CW_BAR); __builtin_amdgcn_fence(__ATOMIC_ACQUIRE, "agent"); }
                __syncthreads();
            }
            pg8::gemm_phase(F.lds, DM, DM, DM, S, E);
            if (rep == 0) small_out(F, l, fuse_fn, fuse_fn);
            if (!(fuse_fn && l + 1 == DEPTH))
        GRID_BAR();
        }
    }
    if (!((F.G == 256) && (REP_PH == 0))) {
        int lane = F.lane; asm volatile("" : "+v"(lane));
        const int gw = F.vcu * NWAVES + F.wave, NGW = F.G * NWAVES;
        const f32x4* gp = (const f32x4*)F.in[I_FNG] + lane; f32x4 gv[4];
#pragma unroll
        for (int j = 0; j < 4; ++j) gv[j] = gp[64 * j];
        const float* rss = F.rss(DEPTH);
        for (int m0 = 4 * gw; m0 < MT; m0 += 4 * NGW) {
            f32x4 v[4][4]; float rs[4];
#pragma unroll
            for (int r = 0; r < 4; ++r) { rs[r] = rss[m0 + r]; const f32x4* xr = (const f32x4*)(F.out + (size_t)(m0 + r) * DM) + lane;
#pragma unroll
                for (int j = 0; j < 4; ++j) v[r][j] = xr[64 * j]; }
#pragma unroll
            for (int r = 0; r < 4; ++r) { const float rstd = rsqrtf(rs[r] * (1.f / DM) + EPS); f32x4* xr = (f32x4*)(F.out + (size_t)(m0 + r) * DM) + lane;
#pragma unroll
                for (int j = 0; j < 4; ++j) xr[64 * j] = v[r][j] * rstd * gv[j]; }
        }
    }
}

extern "C" void kernel_launch(void* const* d_in, const int* in_sizes, int n_in, void* d_out, int out_size, void* d_ws, size_t ws_size, hipStream_t stream) {
    static int grid = 0;
    if (grid == 0) {
        if (n_in != 19 || (size_t)out_size != O_END || ws_size < WS_END) { fprintf(stderr, "kernel_launch: unexpected shapes: n_in %d out %d ws %zu (need %zu / %zu)\n", n_in, out_size, ws_size, (size_t)O_END, (size_t)WS_END); grid = -1; return; }
        int dev = 0, cus = 0, per_cu = 0;
        if (hipGetDevice(&dev) != hipSuccess || hipDeviceGetAttribute(&cus, hipDeviceAttributeMultiprocessorCount, dev) != hipSuccess) { grid = -1; return; }
        if (hipFuncSetAttribute((const void*)fwd_megakernel, hipFuncAttributeMaxDynamicSharedMemorySize, LDS_BYTES) != hipSuccess) { fprintf(stderr, "kernel_launch: hipFuncSetAttribute failed\n"); grid = -1; return; }
        if (hipOccupancyMaxActiveBlocksPerMultiprocessor(&per_cu, (const void*)fwd_megakernel, NWAVES * 64, LDS_BYTES) != hipSuccess || per_cu < 1) { fprintf(stderr, "kernel_launch: occupancy query says %d blocks per CU\n", per_cu); grid = -1; return; }
        (void)hipGetLastError();
        grid = cus;
    }
    if (grid < 0) return;
    (void)hipMemsetAsync((char*)d_ws + WS_CTL, 0, CTL_ZERO_BYTES, stream);
    Args a{};
    for (int i = 0; i < 19; ++i) a.in[i] = (const float*)d_in[i];
    a.out = (float*)d_out; a.ws = (unsigned char*)d_ws;
    hipLaunchKernelGGL(fwd_megakernel, dim3(grid), dim3(NWAVES * 64), LDS_BYTES, stream, a);
}
```
